# Optimizing an MI355X kernel written in HIP

```python
import jax, jax.numpy as jnp
from jax import lax
import numpy as np

D_MODEL = 1024
BATCH = 8
SEQ = 2048
DEPTH = 2
DEC_BATCH = 128
DEC_SEQ = 8
PAST_LEN = 16384
PAGE_SIZE = 128

D_MIX = D_MODEL
D_A = D_MIX // 2
A_HEADS = 8
A_HEAD_DIM = D_A // A_HEADS
CHUNK = 128
D_B = D_MIX // 4
CONV_B = 31
D_C = D_MIX - D_A - D_B
CONV_C = 3
D_IN = 2 * D_A + 2 * D_B + 3 * D_C
D_FF = 4 * D_MODEL
EPS = 1e-6

kernel_name = "hybrid_chunkmlp_conformerconv_shortconv_step"


def rmsnorm(x, g):
    xf = x.astype(jnp.float32)
    y = xf * lax.rsqrt(jnp.mean(xf * xf, axis=-1, keepdims=True) + EPS)
    return (y * g.astype(jnp.float32)).astype(x.dtype)


def layernorm(x, g, b):
    xf = x.astype(jnp.float32)
    mu = jnp.mean(xf, axis=-1, keepdims=True)
    var = jnp.mean(jnp.square(xf - mu), axis=-1, keepdims=True)
    y = (xf - mu) * lax.rsqrt(var + EPS)
    return (y * g.astype(jnp.float32) + b.astype(jnp.float32)).astype(x.dtype)


def causal_dwconv(xpad, w):
    return lax.conv_general_dilated(
        xpad, w[:, None, :].astype(xpad.dtype), window_strides=(1,), padding='VALID',
        dimension_numbers=('NWC', 'WIO', 'NWC'), feature_group_count=xpad.shape[-1])


def spatial_prompt(v, ws_tril, bias):
    n, t, _ = v.shape
    vc = v.reshape(n, t // CHUNK, CHUNK, A_HEADS, A_HEAD_DIM)
    mix = jnp.einsum('hts,ncshd->ncthd', ws_tril, vc) + bias.T[None, None, :, :, None]
    return mix.reshape(n, t, D_A)


def spatial_sample(v, ws_tril, bias):
    n, t, _ = v.shape
    p0 = PAST_LEN % CHUNK
    w = ws_tril[:, p0:p0 + t, p0:p0 + t]
    bb = bias[:, p0:p0 + t]
    vh = v.reshape(n, t, A_HEADS, A_HEAD_DIM)
    mix = jnp.einsum('hts,nshd->nthd', w, vh) + bb.T[None, :, :, None]
    return mix.reshape(n, t, D_A)


def mixer_block(h, hist_b, hist_c, spatial_fn, w_in, a_ln_g, a_ln_b, ws_tril, a_bias,
                b_conv_w, b_conv_b, b_ln_g, b_ln_b, c_conv_w, w_out):
    z = h @ w_in
    s = np.cumsum([D_A, D_A, D_B, D_B, D_C, D_C])
    za_u, za_v, zb_a, zb_g, zc_b, zc_c, zc_x = jnp.split(z, list(s), axis=-1)
    u = jax.nn.gelu(za_u)
    v = layernorm(jax.nn.gelu(za_v), a_ln_g, a_ln_b)
    ya = u * spatial_fn(v, ws_tril, a_bias)
    glu = zb_a * jax.nn.sigmoid(zb_g)
    xb = jnp.concatenate([hist_b, glu], axis=1)
    yb = causal_dwconv(xb, b_conv_w) + b_conv_b
    yb = jax.nn.silu(layernorm(yb, b_ln_g, b_ln_b))
    cx = zc_c * zc_x
    xc = jnp.concatenate([hist_c, cx], axis=1)
    yc = zc_b * causal_dwconv(xc, c_conv_w)
    y = jnp.concatenate([ya, yb, yc], axis=-1) @ w_out
    return (y, xb[:, xb.shape[1] - (CONV_B - 1):], xc[:, xc.shape[1] - (CONV_C - 1):], v)


def setup_inputs(seed: int = 0) -> dict:
    key = jax.random.key(seed)
    ks = jax.random.split(key, 24)
    nrm = lambda k, shp, sc: jax.random.normal(k, shp, jnp.float32) * sc
    return {
        "x_prompt": nrm(ks[0], (BATCH, SEQ, D_MODEL), 1.0),
        "x_sample": nrm(ks[1], (DEC_BATCH, DEC_SEQ, D_MODEL), 1.0),
        "state_conv_b": nrm(ks[2], (DEPTH, DEC_BATCH, CONV_B - 1, D_B), 0.5),
        "state_conv_c": nrm(ks[3], (DEPTH, DEC_BATCH, CONV_C - 1, D_C), 0.5),
        "norm1_g": 1.0 + nrm(ks[4], (DEPTH, D_MODEL), 0.02),
        "w_in": nrm(ks[5], (DEPTH, D_MODEL, D_IN), D_MODEL ** -0.5),
        "a_ln_g": 1.0 + nrm(ks[6], (DEPTH, D_A), 0.02),
        "a_ln_b": nrm(ks[7], (DEPTH, D_A), 0.02),
        "a_ws": nrm(ks[8], (DEPTH, A_HEADS, CHUNK, CHUNK), CHUNK ** -0.5),
        "a_bias": 1.0 + nrm(ks[9], (DEPTH, A_HEADS, CHUNK), 0.02),
        "b_conv_w": nrm(ks[10], (DEPTH, CONV_B, D_B), CONV_B ** -0.5),
        "b_conv_b": nrm(ks[11], (DEPTH, D_B), 0.02),
        "b_ln_g": 1.0 + nrm(ks[12], (DEPTH, D_B), 0.02),
        "b_ln_b": nrm(ks[13], (DEPTH, D_B), 0.02),
        "c_conv_w": nrm(ks[14], (DEPTH, CONV_C, D_C), CONV_C ** -0.5),
        "w_out": nrm(ks[15], (DEPTH, D_MIX, D_MODEL), D_MIX ** -0.5),
        "norm2_g": 1.0 + nrm(ks[16], (DEPTH, D_MODEL), 0.02),
        "w_ff1": nrm(ks[17], (DEPTH, D_MODEL, D_FF), D_MODEL ** -0.5),
        "w_ff2": nrm(ks[18], (DEPTH, D_FF, D_MODEL), D_FF ** -0.5),
        "norm_f_g": 1.0 + nrm(ks[19], (D_MODEL,), 0.02),
    }


def reference(x_prompt, x_sample, state_conv_b, state_conv_c, norm1_g, w_in, a_ln_g, a_ln_b,
              a_ws, a_bias, b_conv_w, b_conv_b, b_ln_g, b_ln_b, c_conv_w, w_out, norm2_g,
              w_ff1, w_ff2, norm_f_g):
    xp, xs = x_prompt, x_sample
    cb_p, cc_p, cb_s, cc_s, v_s = [], [], [], [], []
    for l in range(DEPTH):
        ws_tril = jnp.tril(a_ws[l])
        lw = (w_in[l], a_ln_g[l], a_ln_b[l], ws_tril, a_bias[l], b_conv_w[l], b_conv_b[l],
              b_ln_g[l], b_ln_b[l], c_conv_w[l], w_out[l])
        hp = rmsnorm(xp, norm1_g[l])
        zb = jnp.zeros((xp.shape[0], CONV_B - 1, D_B), xp.dtype)
        zc = jnp.zeros((xp.shape[0], CONV_C - 1, D_C), xp.dtype)
        yp, nbp, ncp, _ = mixer_block(hp, zb, zc, spatial_prompt, *lw)
        xp = xp + yp
        hp = rmsnorm(xp, norm2_g[l])
        xp = xp + jnp.square(jax.nn.relu(hp @ w_ff1[l])) @ w_ff2[l]
        hs = rmsnorm(xs, norm1_g[l])
        ys, nbs, ncs, vs = mixer_block(hs, state_conv_b[l], state_conv_c[l], spatial_sample, *lw)
        xs = xs + ys
        hs = rmsnorm(xs, norm2_g[l])
        xs = xs + jnp.square(jax.nn.relu(hs @ w_ff1[l])) @ w_ff2[l]
        cb_p.append(nbp); cc_p.append(ncp); cb_s.append(nbs); cc_s.append(ncs); v_s.append(vs)
    y_prompt = rmsnorm(xp, norm_f_g)
    y_sample = rmsnorm(xs, norm_f_g)
    new_conv_b_prompt = jnp.stack(cb_p)
    new_conv_c_prompt = jnp.stack(cc_p)
    new_conv_b_sample = jnp.stack(cb_s)
    new_conv_c_sample = jnp.stack(cc_s)
    new_chunk_v_sample = jnp.stack(v_s)
    return (y_prompt, y_sample, new_conv_b_prompt, new_conv_c_prompt, new_conv_b_sample, new_conv_c_sample, new_chunk_v_sample)
```

```cpp
#include <hip/hip_runtime.h>
#include <cstdio>
#include <cstdint>
namespace pg8 {
#define PG8_LAS __attribute__((address_space(3)))
typedef unsigned short bf16_t;
typedef short bf16x8 __attribute__((ext_vector_type(8)));
typedef float f32x4 __attribute__((ext_vector_type(4)));
typedef unsigned u32x4 __attribute__((ext_vector_type(4)));
constexpr int BM = 256, BK = 64, HALF = 128, HTB = HALF * BK * 2  , STAGE_BYTES = 8 * HTB, NXCD = 8, WGM = 8;

__host__ __device__ __forceinline__ int lds_byte(int r, int c) { const int st = (r >> 4) * 2 + (c >> 5), rr = r & 15, cc = c & 31, ob = rr * 64 + cc * 2; return st * 1024 + (ob ^ (((ob >> 9) & 1) << 5)); }
__host__ __device__ __forceinline__ void stage_rc(int b, int& R, int& C) { const int st = b / 1024, sb = b % 1024, swz = sb ^ (((sb >> 9) & 1) << 5); R = (st >> 1) * 16 + swz / 64; C = (st & 1) * 32 + (swz % 64) / 2; }
__host__ __device__ __forceinline__ int perm32(int rho) { const int n = rho >> 4, i = rho & 15; return 8 * (i >> 2) + 4 * n + (i & 3); }

struct Unit { int pm, pn; };
struct Gemm { const bf16_t* A; const bf16_t* Bt; int M, N, K; };

struct StaticOrder {
    int nM, nN, nwg, G, c;
    __host__ __device__ void init(int M, int N, int G_, int c_) { nM = M / BM; nN = N / BM; nwg = nM * nN; G = G_; c = c_; }
    __host__ __device__ bool next(int i, Unit& u) const {
        const long L = (long)i * G + c; if (L >= nwg) return false;
        int wgid = (int)L; { const int q = nwg / NXCD, r = nwg % NXCD, xcd = wgid % NXCD, off = wgid / NXCD; wgid = (xcd < r ? xcd * (q + 1) : r * (q + 1) + (xcd - r) * q) + off; }
        const int nig = WGM * nN, gid = wgid / nig, fm = gid * WGM, gsz = (nM - fm) < WGM ? (nM - fm) : WGM;
        u.pm = fm + ((wgid % nig) % gsz); u.pn = (wgid % nig) / gsz; return true;
    }
    __device__ __forceinline__ void a_ready(const Unit&) const {}
    __device__ __forceinline__ void done(const Unit&) const {}
};

__device__ __forceinline__ unsigned cvt_pk_bf16(float lo, float hi) { unsigned r; asm volatile("v_cvt_pk_bf16_f32 %0, %1, %2" : "=v"(r) : "v"(lo), "v"(hi)); return r; }
typedef float f32x2 __attribute__((ext_vector_type(2)));
constexpr int MP_ROWS = 16384;
constexpr float RMS_EPS = 1e-6f;
__device__ __forceinline__ float fast_sigmoid(float x) { return __builtin_amdgcn_rcpf(1.0f + __builtin_amdgcn_exp2f(-1.4426950408889634f * x)); }
__device__ __forceinline__ float gelu_tanh(float x) {
    const float c1 = -2.0f * 0.7978845608028654f * 1.4426950408889634f, c2 = c1 * 0.044715f;
    const float x2 = x * x, e = __builtin_amdgcn_exp2f(x * (c1 + c2 * x2));
    return x * __builtin_amdgcn_rcpf(1.0f + e);
}
__device__ __forceinline__ void load_rstd(float (&rs)[2][4], const float* SS, int row0, int fq) {
#pragma unroll
    for (int ai = 0; ai < 2; ++ai)
#pragma unroll
        for (int m = 0; m < 4; ++m) {
            const f32x4 p = *(const f32x4*)(SS + (size_t)(row0 + ai * HALF + m * 16) * 16 + 4 * fq);
            float s = (p[0] + p[1]) + (p[2] + p[3]);
            s += __shfl_xor(s, 16); s += __shfl_xor(s, 32);
            rs[ai][m] = __builtin_amdgcn_rsqf(s * (1.0f / 1024.0f) + RMS_EPS);
        }
}
__device__ __forceinline__ u32x4 pack8(const f32x4 a, const f32x4 b) { u32x4 w; w.x = cvt_pk_bf16(a[0], a[1]); w.y = cvt_pk_bf16(a[2], a[3]); w.z = cvt_pk_bf16(b[0], b[1]); w.w = cvt_pk_bf16(b[2], b[3]); return w; }

struct EpiG1 {
    static constexpr bool PERM = true, AFTER_DRAIN = false;
    bf16_t* ZZ; const float* SS; float* cbp; float* ccp; float* cbs; float* ccs;
    __device__ __forceinline__ void operator()(const f32x4 (&acc)[2][2][4][2], const Unit& u, int wr, int wc, int fr, int fq) const {
        const int row0 = u.pm * BM + wr * 64 + fr, pn = u.pn;
        float rs[2][4]; load_rstd(rs, SS, row0, fq);
        if (pn < 4) {
#pragma unroll
            for (int ai = 0; ai < 2; ++ai)
#pragma unroll
                for (int m = 0; m < 4; ++m) { bf16_t* rowp = ZZ + (size_t)(row0 + ai * HALF + m * 16) * 1792 + pn * 256 + wc * 32 + 8 * fq; const float r = rs[ai][m];
#pragma unroll
                    for (int bj = 0; bj < 2; ++bj) { f32x4 v0 = acc[ai][bj][m][0] * r, v1 = acc[ai][bj][m][1] * r;
#pragma unroll
                        for (int i = 0; i < 4; ++i) { v0[i] = gelu_tanh(v0[i]); v1[i] = gelu_tanh(v1[i]); }
                        *(u32x4*)(rowp + bj * HALF) = pack8(v0, v1); } }
        } else if (pn < 8) {
            const bool isB = pn < 6; const int half = pn & 1, ch = 128 * half + wc * 32 + 8 * fq, colbase = (isB ? 1024 : 1280) + ch;
#pragma unroll
            for (int ai = 0; ai < 2; ++ai)
#pragma unroll
                for (int m = 0; m < 4; ++m) { const int row = row0 + ai * HALF + m * 16; const float r = rs[ai][m];
                    f32x4 a0 = acc[ai][0][m][0] * r, a1 = acc[ai][0][m][1] * r, g0 = acc[ai][1][m][0] * r, g1 = acc[ai][1][m][1] * r;
                    if (isB) {
#pragma unroll
                        for (int i = 0; i < 4; ++i) { a0[i] *= fast_sigmoid(g0[i]); a1[i] *= fast_sigmoid(g1[i]); }
                    } else { a0 = a0 * g0; a1 = a1 * g1; }
                    *(u32x4*)(ZZ + (size_t)row * 1792 + colbase) = pack8(a0, a1);
                    float* dst = nullptr;
                    if (row < MP_ROWS) { const int t = row & 2047, b = row >> 11;
                        if (isB) { if (t >= 2018) dst = cbp + (size_t)(b * 30 + (t - 2018)) * 256 + ch; }
                        else     { if (t >= 2046) dst = ccp + (size_t)(b * 2 + (t - 2046)) * 256 + ch; }
                    } else { const int q = row - MP_ROWS, n = q >> 3, t = q & 7;
                        if (isB) dst = cbs + (size_t)(n * 30 + 22 + t) * 256 + ch;
                        else if (t >= 6) dst = ccs + (size_t)(n * 2 + (t - 6)) * 256 + ch;
                    }
                    if (dst) { *(f32x4*)dst = a0; *(f32x4*)(dst + 4) = a1; }
                }
        } else {
#pragma unroll
            for (int ai = 0; ai < 2; ++ai)
#pragma unroll
                for (int m = 0; m < 4; ++m) { bf16_t* rowp = ZZ + (size_t)(row0 + ai * HALF + m * 16) * 1792 + 1536 + wc * 32 + 8 * fq; const float r = rs[ai][m];
#pragma unroll
                    for (int bj = 0; bj < 2; ++bj) *(u32x4*)(rowp + bj * HALF) = pack8(acc[ai][bj][m][0] * r, acc[ai][bj][m][1] * r); }
        }
    }
};
struct EpiG3 {
    static constexpr bool PERM = true, AFTER_DRAIN = false;
    bf16_t* H; const float* SS;
    __device__ __forceinline__ void operator()(const f32x4 (&acc)[2][2][4][2], const Unit& u, int wr, int wc, int fr, int fq) const {
        const int row0 = u.pm * BM + wr * 64 + fr;
        float rs[2][4]; load_rstd(rs, SS, row0, fq);
#pragma unroll
        for (int ai = 0; ai < 2; ++ai)
#pragma unroll
            for (int m = 0; m < 4; ++m) { bf16_t* rowp = H + (size_t)(row0 + ai * HALF + m * 16) * 4096 + u.pn * BM + wc * 32 + 8 * fq; const float r = rs[ai][m];
#pragma unroll
                for (int bj = 0; bj < 2; ++bj) { f32x4 v0 = acc[ai][bj][m][0] * r, v1 = acc[ai][bj][m][1] * r;
#pragma unroll
                    for (int i = 0; i < 4; ++i) { const float a = fmaxf(v0[i], 0.f), b = fmaxf(v1[i], 0.f); v0[i] = a * a; v1[i] = b * b; }
                    *(u32x4*)(rowp + bj * HALF) = pack8(v0, v1); } }
    }
};
struct EpiRes {
    static constexpr bool PERM = false, AFTER_DRAIN = false;
    const float* xin_p; const float* xin_s;
    float* xout; bf16_t* XB; float* SSo;
    __device__ __forceinline__ void operator()(const f32x4 (&acc)[2][2][4][2], const Unit& u, int wr, int wc, int fr, int fq) const {
        typedef unsigned u32x2v __attribute__((ext_vector_type(2)));
        const int row0 = u.pm * BM + wr * 64 + fr, col0 = u.pn * BM + wc * 32 + 4 * fq;
#pragma unroll
        for (int ai = 0; ai < 2; ++ai)
#pragma unroll
            for (int m = 0; m < 4; ++m) { const int row = row0 + ai * HALF + m * 16;
                const float* xi = (u.pm < 64 ? xin_p + (size_t)row * 1024 : xin_s + (size_t)(row - MP_ROWS) * 1024) + col0;
                float* xo = xout + (size_t)row * 1024 + col0; bf16_t* xb = XB + (size_t)row * 1024 + col0; float q = 0.f;
#pragma unroll
                for (int bj = 0; bj < 2; ++bj)
#pragma unroll
                    for (int n = 0; n < 2; ++n) { const f32x4 x = *(const f32x4*)(xi + bj * HALF + n * 16) + acc[ai][bj][m][n];
                        *(f32x4*)(xo + bj * HALF + n * 16) = x; q += (x[0] * x[0] + x[1] * x[1]) + (x[2] * x[2] + x[3] * x[3]);
                        u32x2v w; w.x = cvt_pk_bf16(x[0], x[1]); w.y = cvt_pk_bf16(x[2], x[3]); *(u32x2v*)(xb + bj * HALF + n * 16) = w; }
                q += __shfl_xor(q, 16); q += __shfl_xor(q, 32);
                if (fq == 0) SSo[(size_t)row * 16 + u.pn * 4 + wc] = q;
                if (m & 1) asm volatile("" ::: "memory");
            }
    }
};

template <class Epi, class Sched, bool ALIGN_EPI = false, bool SP2 = false>
__device__ __forceinline__ void gemm_phase(PG8_LAS unsigned char* lds, const Gemm g, const Sched& S, const Epi& E) {
    int tid_ = threadIdx.x; asm volatile("" : "+v"(tid_));
    const int tid = tid_, wid = __builtin_amdgcn_readfirstlane(tid >> 6), lane = tid & 63, wr = wid >> 2, wc = wid & 3, fr = lane & 15, fq = lane >> 4;
    const int K = g.K, nt = K / BK;
    unsigned voffA[2], voffB[2];
#pragma unroll
    for (int i = 0; i < 2; ++i) { int R, C; stage_rc(tid * 16 + i * 8192, R, C); const int Rb = Epi::PERM ? ((R & ~31) + perm32(R & 31)) : R;
        voffA[i] = (unsigned)(R * K + C) * 2u; voffB[i] = (unsigned)(Rb * K + C) * 2u; }
    const size_t kstep = (size_t)(BK * 2);
    const size_t hstep = (size_t)HALF * K * 2;
    const size_t tstep = 2 * hstep;
    const unsigned ldsw = (unsigned)wid * 1024u;
    const int aoff = lds_byte(wr * 64 + fr, fq * 8), boff = lds_byte(wc * 32 + fr, fq * 8);
#define PG8_SA(b, h) (((b) * 2 + (h)) * HTB)
#define PG8_SB(b, h) ((4 + (b) * 2 + (h)) * HTB)
#define PG8_STAGE(bufoff, gbase, voff) do { _Pragma("unroll") for (int _i = 0; _i < 2; ++_i) \
        __builtin_amdgcn_global_load_lds((const unsigned*)((const char*)(gbase) + (voff)[_i]), (PG8_LAS unsigned*)(lds + (bufoff) + ldsw + _i * 8192), 16, 0, 0); } while (0)
#define PG8_LDA(dst, b, h) do { _Pragma("unroll") for (int m = 0; m < 4; ++m) _Pragma("unroll") for (int k = 0; k < 2; ++k) dst[m][k] = *(const PG8_LAS bf16x8*)(lds + PG8_SA(b, h) + aoff + m * 2048 + k * 1024); } while (0)
#define PG8_LDB(dst, b, h) do { _Pragma("unroll") for (int n = 0; n < 2; ++n) _Pragma("unroll") for (int k = 0; k < 2; ++k) dst[n][k] = *(const PG8_LAS bf16x8*)(lds + PG8_SB(b, h) + boff + n * 2048 + k * 1024); } while (0)
#define PG8_MMA(ai, bj, At, Bt) do { __builtin_amdgcn_s_setprio(1); _Pragma("unroll") for (int m = 0; m < 4; ++m) _Pragma("unroll") for (int n = 0; n < 2; ++n) _Pragma("unroll") for (int k = 0; k < 2; ++k) \
        acc[ai][bj][m][n] = __builtin_amdgcn_mfma_f32_16x16x32_bf16(Bt[n][k], At[m][k], acc[ai][bj][m][n], 0, 0, 0); __builtin_amdgcn_s_setprio(0); } while (0)
#define PG8_WAIT_V(n) asm volatile("s_waitcnt vmcnt(" #n ")" ::: "memory")
#define PG8_WAIT_L(n) asm volatile("s_waitcnt lgkmcnt(" #n ")" ::: "memory")
#define PG8_BAR __builtin_amdgcn_s_barrier()
#define PG8_SCHED __builtin_amdgcn_sched_barrier(0)
    Unit cur, nxt; int ui = 0;
    if (!S.next(0, cur)) return;
    f32x4 acc[2][2][4][2];
#pragma unroll
    for (int a = 0; a < 2; ++a)
#pragma unroll
        for (int b = 0; b < 2; ++b)
#pragma unroll
            for (int m = 0; m < 4; ++m)
#pragma unroll
                for (int n = 0; n < 2; ++n) acc[a][b][m][n] = (f32x4){0.f, 0.f, 0.f, 0.f};
    bf16x8 At[4][2], B0[2][2], B1[2][2];
    const char* cA = (const char*)g.A + (size_t)cur.pm * tstep; const char* cB = (const char*)g.Bt + (size_t)cur.pn * tstep;
    S.a_ready(cur);
    if constexpr (SP2) {
        PG8_STAGE(PG8_SB(0, 0), cB, voffB); PG8_STAGE(PG8_SB(0, 1), cB + hstep, voffB); PG8_STAGE(PG8_SA(0, 0), cA, voffA); PG8_STAGE(PG8_SA(0, 1), cA + hstep, voffA);
        if (wr == 1) PG8_BAR;
        PG8_WAIT_V(2); PG8_BAR;
        PG8_STAGE(PG8_SB(1, 0), cB + kstep, voffB); PG8_STAGE(PG8_SA(1, 0), cA + kstep, voffA); PG8_STAGE(PG8_SB(1, 1), cB + hstep + kstep, voffB);
        PG8_WAIT_V(6); PG8_BAR;
    } else {
        PG8_STAGE(PG8_SB(0, 0), cB, voffB); PG8_STAGE(PG8_SA(0, 0), cA, voffA); PG8_STAGE(PG8_SB(0, 1), cB + hstep, voffB); PG8_STAGE(PG8_SA(0, 1), cA + hstep, voffA);
        if (wr == 1) PG8_BAR;
        PG8_WAIT_V(4); PG8_BAR;
        PG8_STAGE(PG8_SB(1, 0), cB + kstep, voffB); PG8_STAGE(PG8_SA(1, 0), cA + kstep, voffA); PG8_STAGE(PG8_SB(1, 1), cB + hstep + kstep, voffB);
        PG8_WAIT_V(6); PG8_BAR;
    }
    for (;;) {
        const bool has_next = S.next(ui + 1, nxt);
        const char* nA = has_next ? (const char*)g.A + (size_t)nxt.pm * tstep : cA; const char* nB = has_next ? (const char*)g.Bt + (size_t)nxt.pn * tstep : cB;
        for (int t = 0; t < nt; t += 2) {
            const bool last = (t == nt - 2);
            const char* a1 = cA + (size_t)(t + 1) * kstep;
            const char* a2 = last ? nA : cA + (size_t)(t + 2) * kstep; const char* b2 = last ? nB : cB + (size_t)(t + 2) * kstep;
            const char* a3 = a2 + kstep; const char* b3 = b2 + kstep;
            if (last && has_next) S.a_ready(nxt);
            if constexpr (SP2) {
            PG8_LDB(B0, 0, 0); PG8_LDB(B1, 0, 1); PG8_SCHED; PG8_LDA(At, 0, 0); PG8_STAGE(PG8_SA(1, 1), a1 + hstep, voffA);
            PG8_WAIT_V(8); PG8_WAIT_L(0); PG8_BAR; PG8_MMA(0, 0, At, B0); PG8_MMA(0, 1, At, B1); PG8_BAR; PG8_SCHED;
            PG8_LDA(At, 0, 1); PG8_STAGE(PG8_SB(0, 0), b2, voffB); PG8_STAGE(PG8_SB(0, 1), b2 + hstep, voffB); PG8_STAGE(PG8_SA(0, 0), a2, voffA);
            PG8_WAIT_V(8); PG8_WAIT_L(0); PG8_BAR; PG8_MMA(1, 0, At, B0); PG8_MMA(1, 1, At, B1); PG8_BAR; PG8_SCHED;
            PG8_LDB(B0, 1, 0); PG8_LDB(B1, 1, 1); PG8_SCHED; PG8_LDA(At, 1, 0); PG8_STAGE(PG8_SA(0, 1), a2 + hstep, voffA);
            PG8_WAIT_V(8); PG8_WAIT_L(0); PG8_BAR; PG8_MMA(0, 0, At, B0); PG8_MMA(0, 1, At, B1); PG8_BAR; PG8_SCHED;
            PG8_LDA(At, 1, 1); PG8_STAGE(PG8_SB(1, 0), b3, voffB); PG8_STAGE(PG8_SB(1, 1), b3 + hstep, voffB); PG8_STAGE(PG8_SA(1, 0), a3, voffA);
            PG8_WAIT_V(8); PG8_WAIT_L(0); PG8_BAR; PG8_MMA(1, 0, At, B0); PG8_MMA(1, 1, At, B1); PG8_BAR; PG8_SCHED;
            } else {
            PG8_LDB(B0, 0, 0); PG8_SCHED; PG8_LDA(At, 0, 0); PG8_STAGE(PG8_SA(1, 1), a1 + hstep, voffA);
            PG8_WAIT_L(8); PG8_BAR; PG8_WAIT_L(0); PG8_MMA(0, 0, At, B0); PG8_BAR; PG8_SCHED;
            PG8_LDB(B1, 0, 1); PG8_STAGE(PG8_SB(0, 0), b2, voffB);
            PG8_BAR; PG8_WAIT_L(0); PG8_MMA(0, 1, At, B1); PG8_BAR;
            PG8_LDA(At, 0, 1); PG8_STAGE(PG8_SA(0, 0), a2, voffA);
            PG8_BAR; PG8_WAIT_L(0); PG8_MMA(1, 0, At, B0); PG8_BAR; PG8_SCHED;
            PG8_STAGE(PG8_SB(0, 1), b2 + hstep, voffB);
            PG8_WAIT_V(6); PG8_BAR; PG8_MMA(1, 1, At, B1); PG8_BAR;
            PG8_LDB(B0, 1, 0); PG8_SCHED; PG8_LDA(At, 1, 0); PG8_STAGE(PG8_SA(0, 1), a2 + hstep, voffA);
            PG8_WAIT_L(8); PG8_BAR; PG8_WAIT_L(0); PG8_MMA(0, 0, At, B0); PG8_BAR; PG8_SCHED;
            PG8_LDB(B1, 1, 1); PG8_STAGE(PG8_SB(1, 0), b3, voffB);
            PG8_BAR; PG8_WAIT_L(0); PG8_MMA(0, 1, At, B1); PG8_BAR;
            PG8_LDA(At, 1, 1); PG8_STAGE(PG8_SA(1, 0), a3, voffA);
            PG8_BAR; PG8_WAIT_L(0); PG8_MMA(1, 0, At, B0); PG8_BAR; PG8_SCHED;
            PG8_STAGE(PG8_SB(1, 1), b3 + hstep, voffB);
            PG8_WAIT_V(6); PG8_BAR; PG8_MMA(1, 1, At, B1); PG8_BAR;
            }
        }
        if constexpr (ALIGN_EPI) { if (wr == 0) PG8_BAR; }
        if constexpr (!Epi::AFTER_DRAIN) { E(acc, cur, wr, wc, fr, fq); S.done(cur); }
        if (!has_next) break;
#pragma unroll
        for (int a = 0; a < 2; ++a)
#pragma unroll
            for (int b = 0; b < 2; ++b)
#pragma unroll
                for (int m = 0; m < 4; ++m)
#pragma unroll
                    for (int n = 0; n < 2; ++n) acc[a][b][m][n] = (f32x4){0.f, 0.f, 0.f, 0.f};
        cur = nxt; cA = nA; cB = nB; ++ui;
        if constexpr (ALIGN_EPI) { if (wr == 1) PG8_BAR; }
    }
    PG8_WAIT_V(0);
    if constexpr (!ALIGN_EPI) { if (wr == 0) PG8_BAR; }
    PG8_BAR;
    if constexpr (Epi::AFTER_DRAIN) { E.fused(acc, cur, wr, wc, fr, fq, lds, wid, lane); S.done(cur); }
#undef PG8_SA
#undef PG8_SB
#undef PG8_STAGE
#undef PG8_LDA
#undef PG8_LDB
#undef PG8_MMA
#undef PG8_WAIT_V
#undef PG8_WAIT_L
#undef PG8_BAR
#undef PG8_SCHED
}
}
#define GAS __attribute__((address_space(1)))
#define LAS __attribute__((address_space(3)))
typedef unsigned short bf16;
typedef unsigned v4u __attribute__((ext_vector_type(4)));
typedef float f32x4 __attribute__((ext_vector_type(4)));
typedef short bf16x8 __attribute__((ext_vector_type(8)));
typedef GAS unsigned gu32;
typedef GAS unsigned long long gu64;
#define RLX_AGENT __ATOMIC_RELAXED, __HIP_MEMORY_SCOPE_AGENT
#define LDS_WAIT() asm volatile("s_waitcnt lgkmcnt(0)" ::: "memory")
#define VM_WAIT() asm volatile("s_waitcnt vmcnt(0)" ::: "memory")
__device__ __forceinline__ unsigned long long rt() { return __builtin_amdgcn_s_memrealtime(); }
__device__ __forceinline__ unsigned f2bf(float f) { unsigned u = __builtin_bit_cast(unsigned, f); return (u + 0x7fffu + ((u >> 16) & 1u)) >> 16; }
__device__ __forceinline__ unsigned pk2(float lo, float hi) { return f2bf(lo) | (f2bf(hi) << 16); }

#define XB_TMO      128
#define XB_XCNT(j)  (256  + 64 * (j))
#define XB_XSUB(j)  (1280 + 64 * (j))
#define XB_XGEN(j)  (2304 + 64 * (j))
#define XB_TOP      3328
#define XB_TOPGEN   3392
#define XCD_BAR_WORDS 3456
#define XB_SPIN_CAP (1u << 18)

__device__ __forceinline__ unsigned xb_ld(unsigned* p)              { return __hip_atomic_load(p, __ATOMIC_RELAXED, __HIP_MEMORY_SCOPE_AGENT); }
__device__ __forceinline__ unsigned xb_add(unsigned* p, unsigned v) { return __hip_atomic_fetch_add(p, v, __ATOMIC_RELAXED, __HIP_MEMORY_SCOPE_AGENT); }
__device__ __forceinline__ unsigned xb_xcc_id() { return (unsigned)__builtin_amdgcn_s_getreg((3 << 11) | 20) & 0xFu; }
#define XB_SPIN(cond, bar) do { unsigned _sp = 0; while (cond) { __builtin_amdgcn_s_sleep(1); \
    if ((++_sp & 255u) == 0u) { if (xb_ld(&(bar)[XB_TMO])) break; if (_sp > XB_SPIN_CAP) { atomicAdd(&(bar)[XB_TMO], 1u); break; } } } } while (0)

struct XcdBarrier {
    unsigned* bar; unsigned x;
    volatile LAS unsigned* st;
};

__device__ __forceinline__ XcdBarrier xcd_barrier_post(unsigned* bar, volatile LAS unsigned* st) {
    XcdBarrier b; b.bar = bar; b.x = xb_xcc_id(); b.st = st;
    if (threadIdx.x == 0) (void)xb_add(&bar[XB_XCNT(b.x)], 1u);
    return b;
}
__device__ __forceinline__ void xcd_barrier_complete(unsigned* bar, unsigned x, unsigned& nloc, unsigned& nx) {
    const unsigned G = gridDim.x * gridDim.y * gridDim.z;
    unsigned sum, cnt, mine, sp = 0u;
    for (;;) {
        sum = 0u; cnt = 0u; mine = 0u;
#pragma unroll
        for (unsigned j = 0; j < 16; ++j) { const unsigned c = xb_ld(&bar[XB_XCNT(j)]); sum += c; cnt += (c > 0u) ? 1u : 0u; mine = (j == x) ? c : mine; }
        if (sum == G) break;
        __builtin_amdgcn_s_sleep(1);
        if ((++sp & 255u) == 0u) { if (xb_ld(&bar[XB_TMO])) break; if (sp > XB_SPIN_CAP) { atomicAdd(&bar[XB_TMO], 1u); break; } }
    }
    nloc = mine > 0u ? mine : 1u; nx = cnt > 0u ? cnt : 1u;
}

__device__ __forceinline__ void xcd_barrier(const XcdBarrier& b) {
    asm volatile("s_waitcnt vmcnt(0)" ::: "memory");
    __syncthreads();
    if (threadIdx.x == 0) {
        unsigned* bar = b.bar;
        __builtin_amdgcn_s_waitcnt(0);
        unsigned nloc = b.st[0], nx = b.st[1];
        if (nloc == 0u) { xcd_barrier_complete(bar, b.x, nloc, nx); b.st[0] = nloc; b.st[1] = nx; }
        const unsigned old = xb_add(&bar[XB_XSUB(b.x)], 1u);
        const unsigned gen = old / nloc;
        if (old + 1u == (gen + 1u) * nloc) {
            __builtin_amdgcn_fence(__ATOMIC_RELEASE, "agent");
            asm volatile("s_waitcnt vmcnt(0)" ::: "memory");
            const unsigned og = xb_add(&bar[XB_TOP], 1u);
            const unsigned tg = og / nx;
            if (og + 1u == (tg + 1u) * nx) xb_add(&bar[XB_TOPGEN], 1u);
            else XB_SPIN(xb_ld(&bar[XB_TOPGEN]) == tg, bar);
            __builtin_amdgcn_fence(__ATOMIC_ACQUIRE, "agent");
            xb_add(&bar[XB_XGEN(b.x)], 1u);
            asm volatile("s_waitcnt vmcnt(0)" ::: "memory");
        } else {
            XB_SPIN(xb_ld(&bar[XB_XGEN(b.x)]) == gen, bar);
            __builtin_amdgcn_fence(__ATOMIC_ACQUIRE, "agent");
            asm volatile("s_waitcnt vmcnt(0)" ::: "memory");
        }
    }
    __syncthreads();
}

#ifndef MK_N_LAUNCHES
#define MK_N_LAUNCHES 1
#endif
constexpr int NWAVES = 8;
constexpr int NPH = 12;
constexpr int N_LAUNCHES = MK_N_LAUNCHES;
constexpr int D = 1024, DIN = 2304, DFF = 4096, DA = 512, DB = 256, DC = 256, DEPTH = 2;
constexpr int MP = 16384, MS = 1024, M = MP + MS, SEQ = 2048, NSEQ_S = 128, TS = 8;
constexpr int ZP = 1792;
constexpr float EPS = 1e-6f;
constexpr size_t O_Y = 0, O_CBP = (size_t)M * D, O_CCP = O_CBP + (size_t)DEPTH * 8 * 30 * DB, O_CBS = O_CCP + (size_t)DEPTH * 8 * 2 * DC,
                 O_CCS = O_CBS + (size_t)DEPTH * NSEQ_S * 30 * DB, O_V = O_CCS + (size_t)DEPTH * NSEQ_S * 2 * DC, O_END = O_V + (size_t)DEPTH * NSEQ_S * TS * DA;
constexpr size_t MiB = 1u << 20;
constexpr size_t WS_CTL = 0, CTL_ZERO_BYTES = 1 * MiB;
constexpr size_t WS_W = 2 * MiB, W_LAYER = 22 * MiB + MiB / 2, W1_OFF = 0, W2_OFF = 4 * MiB + MiB / 2, W3_OFF = 6 * MiB + MiB / 2, W4_OFF = 14 * MiB + MiB / 2;
constexpr size_t WS_WST = 47 * MiB;
constexpr size_t WS_SS = 48 * MiB, SS_STRIDE = MiB + MiB / 4;
constexpr size_t WS_XB = 56 * MiB;
constexpr size_t WS_ZZ = 90 * MiB;
constexpr size_t WS_YC = 150 * MiB;
constexpr size_t WS_HFF = 90 * MiB;
constexpr size_t WS_END = 226 * MiB;
static_assert(WS_W + 2 * W_LAYER <= WS_WST && WS_SS + 5 * SS_STRIDE <= WS_XB && WS_XB + (size_t)M * D * 2 <= WS_ZZ && WS_ZZ + (size_t)M * ZP * 2 <= WS_YC && WS_YC + (size_t)M * D * 2 <= WS_END && WS_HFF + (size_t)M * DFF * 2 <= WS_END, "ws map");
constexpr int CW_BAR = 4096;
constexpr int RING_BYTES = 135168;
constexpr int LDSCTL_OFF = RING_BYTES, MISC_OFF = LDSCTL_OFF + 320;
constexpr int LDS_BYTES = 147456;
constexpr int VI_PITCH = 1032;
static_assert(128 * VI_PITCH <= RING_BYTES && MISC_OFF + 128 <= LDS_BYTES, "LDS map");

typedef unsigned u32x2 __attribute__((ext_vector_type(2)));
using pg8::cvt_pk_bf16;
__device__ __forceinline__ f32x4 unpack4(u32x2 p) { f32x4 r; r[0] = __uint_as_float(p.x << 16); r[1] = __uint_as_float(p.x & 0xffff0000u); r[2] = __uint_as_float(p.y << 16); r[3] = __uint_as_float(p.y & 0xffff0000u); return r; }
__device__ __forceinline__ u32x2 pack4(f32x4 v) { u32x2 r; r.x = cvt_pk_bf16(v[0], v[1]); r.y = cvt_pk_bf16(v[2], v[3]); return r; }
__device__ __forceinline__ float wave_sum(float v) {
#pragma unroll
    for (int o = 1; o < 64; o <<= 1) v += __shfl_xor(v, o);
    return v;
}
__device__ __forceinline__ float sum4(f32x4 v) { return (v[0] + v[1]) + (v[2] + v[3]); }
__device__ __forceinline__ float sumsq4(f32x4 v) { return (v[0] * v[0] + v[1] * v[1]) + (v[2] * v[2] + v[3] * v[3]); }

struct Args { const float* in[20]; float* out; unsigned char* ws; int ph_lo, ph_hi, li, pad; };

__device__ __forceinline__ void transpose_item(const float* W, int K, int N, bf16* WT, const float* g, int k0, int ns0, int nd0, LAS float* scr, int lane) {
#pragma unroll 8
    for (int i = 0; i < 32; ++i) { const int kk = 2 * i + (lane >> 5); float v = W[(size_t)(k0 + kk) * N + ns0 + (lane & 31)]; if (g) v *= g[k0 + kk]; scr[kk * 33 + (lane & 31)] = v; }
    LDS_WAIT(); asm volatile("" ::: "memory");
    const int c = lane & 7;
#pragma unroll
    for (int j = 0; j < 4; ++j) { const int n = (lane >> 3) + 8 * j; const LAS float* s = scr + (8 * c) * 33 + n;
        v4u o; o.x = pk2(s[0 * 33], s[1 * 33]); o.y = pk2(s[2 * 33], s[3 * 33]); o.z = pk2(s[4 * 33], s[5 * 33]); o.w = pk2(s[6 * 33], s[7 * 33]);
        *(GAS v4u*)(WT + (size_t)(nd0 + n) * K + k0 + 8 * c) = o; }
    LDS_WAIT(); asm volatile("" ::: "memory");
}
__device__ __forceinline__ int win_src_col(int np) {
    const int t = np >> 8, j = np & 255;
    if (t < 4) return np;
    if (t < 6) return (j < 128 ? 1024 : 1280) + 128 * (t - 4) + (j & 127);
    if (t < 8) return (j < 128 ? 1792 : 2048) + 128 * (t - 6) + (j & 127);
    return 1536 + j;
}

struct MixArgs {
    const bf16* ZZ; bf16* YC; const bf16* WST;
    const float *ln_g, *ln_b, *a_bias, *a_ws, *bw, *bb, *blg, *blb, *cw;
    const float *st_b, *st_c;
    float *o_cbs, *o_v;
};

template <class WinB, class WinC>
__device__ __forceinline__ void conv_rows(int rowbase, const MixArgs& A, int lane, WinB winb, WinC winc) {
    const int c4 = 4 * lane;
    {
        u32x2 win[38];
#pragma unroll
        for (int j = 0; j < 38; ++j) win[j] = winb(j);
        f32x4 acc[8]; const f32x4 cb = *(const f32x4*)(A.bb + c4);
#pragma unroll
        for (int r = 0; r < 8; ++r) acc[r] = cb;
#pragma unroll
        for (int k = 0; k < 31; ++k) { const f32x4 wk = *(const f32x4*)(A.bw + k * 256 + c4);
#pragma unroll
            for (int r = 0; r < 8; ++r) acc[r] += wk * unpack4(win[r + k]); }
        const f32x4 lg = *(const f32x4*)(A.blg + c4), lb = *(const f32x4*)(A.blb + c4);
#pragma unroll
        for (int r = 0; r < 8; ++r) {
            const float mu = wave_sum(sum4(acc[r])) * (1.0f / 256.0f);
            const f32x4 d = acc[r] - mu;
            const float rstd = __builtin_amdgcn_rsqf(wave_sum(sumsq4(d)) * (1.0f / 256.0f) + EPS);
            f32x4 y = d * rstd * lg + lb;
#pragma unroll
            for (int i = 0; i < 4; ++i) y[i] = y[i] * pg8::fast_sigmoid(y[i]);
            *(u32x2*)(A.YC + (size_t)(rowbase + r) * D + 512 + c4) = pack4(y);
        }
    }
    {
        u32x2 w2[10];
#pragma unroll
        for (int j = 0; j < 10; ++j) w2[j] = winc(j);
        const f32x4 k0 = *(const f32x4*)(A.cw + c4), k1 = *(const f32x4*)(A.cw + 256 + c4), k2 = *(const f32x4*)(A.cw + 512 + c4);
#pragma unroll
        for (int r = 0; r < 8; ++r) {
            const f32x4 cv = k0 * unpack4(w2[r]) + k1 * unpack4(w2[r + 1]) + k2 * unpack4(w2[r + 2]);
            const f32x4 zb = unpack4(*(const u32x2*)(A.ZZ + (size_t)(rowbase + r) * ZP + 1536 + c4));
            *(u32x2*)(A.YC + (size_t)(rowbase + r) * D + 768 + c4) = pack4(zb * cv);
        }
    }
}

__device__ __forceinline__ void mixer_prompt_unit(LAS unsigned char* lds, int unit, const MixArgs& A, int wave, int lane_in) {
    int lane = lane_in; asm volatile("" : "+v"(lane));
    const int r0 = unit * 64, b = r0 >> 11, t0 = r0 & 2047, jh = (t0 >> 6) & 1, rc = r0 - 64 * jh, nv = 64 * (jh + 1);
    {
        const f32x4 g0 = *(const f32x4*)(A.ln_g + 8 * lane), g1 = *(const f32x4*)(A.ln_g + 8 * lane + 4), b0 = *(const f32x4*)(A.ln_b + 8 * lane), b1 = *(const f32x4*)(A.ln_b + 8 * lane + 4);
        for (int s = wave; s < nv; s += 8) {
            const v4u raw = *(const v4u*)(A.ZZ + (size_t)(rc + s) * ZP + 512 + 8 * lane);
            f32x4 x0 = unpack4((u32x2){raw.x, raw.y}), x1 = unpack4((u32x2){raw.z, raw.w});
            const float mu = wave_sum(sum4(x0) + sum4(x1)) * (1.0f / 512.0f);
            x0 = x0 - mu; x1 = x1 - mu;
            const float rstd = __builtin_amdgcn_rsqf(wave_sum(sumsq4(x0) + sumsq4(x1)) * (1.0f / 512.0f) + EPS);
            x0 = x0 * rstd * g0 + b0; x1 = x1 * rstd * g1 + b1;
            LAS u32x2* dst = (LAS u32x2*)(lds + s * VI_PITCH + 16 * lane);
            dst[0] = pack4(x0); dst[1] = pack4(x1);
        }
    }
    __syncthreads();
    {
        const int h = wave, l15 = lane & 15, kg = lane >> 4, nks = nv >> 5;
        bf16x8 afr[4][4];
#pragma unroll
        for (int df = 0; df < 4; ++df)
#pragma unroll
            for (int ks = 0; ks < 4; ++ks) {
                if (ks < nks) {
#pragma unroll
                    for (int j = 0; j < 8; ++j) afr[df][ks][j] = *(const LAS short*)(lds + (32 * ks + 8 * kg + j) * VI_PITCH + 2 * (h * 64 + 16 * df + l15));
                } else afr[df][ks] = (bf16x8){0, 0, 0, 0, 0, 0, 0, 0};
            }
        f32x4 acc[4][4];
#pragma unroll
        for (int df = 0; df < 4; ++df)
#pragma unroll
            for (int tf = 0; tf < 4; ++tf) acc[df][tf] = (f32x4){0.f, 0.f, 0.f, 0.f};
        const bf16* Wh = A.WST + (size_t)h * 128 * 128;
#pragma unroll
        for (int tf = 0; tf < 4; ++tf) {
            const int tl = 64 * jh + 16 * tf + l15, ksmax = (64 * jh + 16 * tf + 15) >> 5;
#pragma unroll
            for (int ks = 0; ks < 4; ++ks) if (ks <= ksmax) {
                const bf16x8 bfr = *(const bf16x8*)(Wh + (size_t)tl * 128 + 32 * ks + 8 * kg);
#pragma unroll
                for (int df = 0; df < 4; ++df) acc[df][tf] = __builtin_amdgcn_mfma_f32_16x16x32_bf16(afr[df][ks], bfr, acc[df][tf], 0, 0, 0);
            }
        }
#pragma unroll
        for (int tf = 0; tf < 4; ++tf) {
            const int tl = 64 * jh + 16 * tf + l15, row = rc + tl; const float bias = A.a_bias[h * 128 + tl];
#pragma unroll
            for (int df = 0; df < 4; ++df) { const int col = h * 64 + 16 * df + 4 * kg;
                const f32x4 u4 = unpack4(*(const u32x2*)(A.ZZ + (size_t)row * ZP + col));
                *(u32x2*)(A.YC + (size_t)row * D + col) = pack4(u4 * (acc[df][tf] + bias)); }
        }
    }
    {
        const int p0 = t0 + 8 * wave, c4 = 4 * lane; const bf16* zs = A.ZZ + (size_t)(b * SEQ) * ZP;
        conv_rows(r0 + 8 * wave, A, lane,
            [&](int j) -> u32x2 { const int p = p0 - 30 + j; return p >= 0 ? *(const u32x2*)(zs + (size_t)p * ZP + 1024 + c4) : (u32x2){0u, 0u}; },
            [&](int j) -> u32x2 { const int p = p0 - 2 + j;  return p >= 0 ? *(const u32x2*)(zs + (size_t)p * ZP + 1280 + c4) : (u32x2){0u, 0u}; });
    }
    __syncthreads();
}

__device__ __forceinline__ void mixer_sample_unit(int su, const MixArgs& A, int wave, int lane_in) {
    int lane = lane_in; asm volatile("" : "+v"(lane));
    const int n = 8 * su + wave, rb = MP + 8 * n, c4 = 4 * lane;
    {
        const f32x4 g0 = *(const f32x4*)(A.ln_g + 8 * lane), g1 = *(const f32x4*)(A.ln_g + 8 * lane + 4), b0 = *(const f32x4*)(A.ln_b + 8 * lane), b1 = *(const f32x4*)(A.ln_b + 8 * lane + 4);
        f32x4 v0[8], v1[8];
#pragma unroll
        for (int t = 0; t < 8; ++t) {
            const v4u raw = *(const v4u*)(A.ZZ + (size_t)(rb + t) * ZP + 512 + 8 * lane);
            f32x4 x0 = unpack4((u32x2){raw.x, raw.y}), x1 = unpack4((u32x2){raw.z, raw.w});
            const float mu = wave_sum(sum4(x0) + sum4(x1)) * (1.0f / 512.0f);
            x0 = x0 - mu; x1 = x1 - mu;
            const float rstd = __builtin_amdgcn_rsqf(wave_sum(sumsq4(x0) + sumsq4(x1)) * (1.0f / 512.0f) + EPS);
            x0 = x0 * rstd * g0 + b0; x1 = x1 * rstd * g1 + b1;
            v0[t] = x0; v1[t] = x1;
            float* ov = A.o_v + (size_t)(n * TS + t) * DA + 8 * lane; *(f32x4*)ov = x0; *(f32x4*)(ov + 4) = x1;
        }
        const int h = lane >> 3;
#pragma unroll
        for (int t = 0; t < 8; ++t) {
            const float bias = A.a_bias[h * 128 + t]; f32x4 m0 = (f32x4){bias, bias, bias, bias}, m1 = m0;
#pragma unroll
            for (int s = 0; s <= t; ++s) { const float w = A.a_ws[(size_t)(h * 128 + t) * 128 + s]; m0 += w * v0[s]; m1 += w * v1[s]; }
            const v4u raw = *(const v4u*)(A.ZZ + (size_t)(rb + t) * ZP + 8 * lane);
            const f32x4 u0 = unpack4((u32x2){raw.x, raw.y}), u1 = unpack4((u32x2){raw.z, raw.w});
            const u32x2 p0 = pack4(u0 * m0), p1 = pack4(u1 * m1);
            *(v4u*)(A.YC + (size_t)(rb + t) * D + 8 * lane) = (v4u){p0.x, p0.y, p1.x, p1.y};
        }
    }
    const float* sb = A.st_b + (size_t)n * 30 * DB; const float* sc = A.st_c + (size_t)n * 2 * DC;
#pragma unroll
    for (int j = 8; j < 30; ++j) *(f32x4*)(A.o_cbs + (size_t)(n * 30 + j - 8) * DB + c4) = *(const f32x4*)(sb + j * DB + c4);
    conv_rows(rb, A, lane,
        [&](int j) -> u32x2 { return j < 30 ? pack4(*(const f32x4*)(sb + j * DB + c4)) : *(const u32x2*)(A.ZZ + (size_t)(rb + j - 30) * ZP + 1024 + c4); },
        [&](int j) -> u32x2 { return j < 2 ? pack4(*(const f32x4*)(sc + j * DC + c4)) : *(const u32x2*)(A.ZZ + (size_t)(rb + j - 2) * ZP + 1280 + c4); });
}

__global__ void __launch_bounds__(NWAVES * 64, 2) fwd_kernel(Args args) {
    extern __shared__ __attribute__((aligned(16))) unsigned char lds_raw[];
    LAS unsigned char* lds = (LAS unsigned char*)lds_raw;
    volatile LAS unsigned* MISC = (volatile LAS unsigned*)(lds + MISC_OFF);
    const int tid = threadIdx.x, lane = tid & 63, wave = __builtin_amdgcn_readfirstlane(tid >> 6);
    const int G = gridDim.x, bx = blockIdx.x;
    const int gw = bx * NWAVES + wave, NGW = G * NWAVES;
    unsigned char* ws = args.ws; float* out = args.out;
    gu32* ctl = (gu32*)(ws + WS_CTL);
    for (int u = tid; u < (LDS_BYTES - LDSCTL_OFF) / 4; u += NWAVES * 64) ((LAS unsigned*)(lds + LDSCTL_OFF))[u] = 0u;
    __syncthreads();
    XcdBarrier bar; bar.bar = (unsigned*)(ctl + CW_BAR); bar.x = 0; bar.st = nullptr;
    if (N_LAUNCHES == 1) bar = xcd_barrier_post((unsigned*)(ctl + CW_BAR), MISC + 8);
    const int lo = args.ph_lo, hi = args.ph_hi;
#define IN(k) (lo <= (k) && (k) < hi)
#define SEAM(k) do { if (IN(k) && IN((k) + 1)) xcd_barrier(bar); } while (0)

    const float* x_prompt = args.in[0]; const float* x_sample = args.in[1];
    bf16* XB = (bf16*)(ws + WS_XB); bf16* ZZ = (bf16*)(ws + WS_ZZ); bf16* YC = (bf16*)(ws + WS_YC); bf16* HFF = (bf16*)(ws + WS_HFF);

    if (IN(0)) {
        LAS float* scr = (LAS float*)(lds + wave * 16384);
        constexpr int I1 = (D / 64) * (DIN / 32), I2 = (D / 64) * (D / 32), I3 = (D / 64) * (DFF / 32), I4 = (DFF / 64) * (D / 32), IL = I1 + I2 + I3 + I4;
        for (int it = gw; it < DEPTH * IL; it += NGW) {
            const int l = it / IL; int r = it - l * IL; unsigned char* wl = ws + WS_W + (size_t)l * W_LAYER;
            if (r < I1) { const int nb = r % (DIN / 32), kb = r / (DIN / 32);
                transpose_item(args.in[5] + (size_t)l * D * DIN, D, DIN, (bf16*)(wl + W1_OFF), args.in[4] + l * D, 64 * kb, win_src_col(32 * nb), 32 * nb, scr, lane); continue; }
            r -= I1;
            if (r < I2) { const int nb = r % (D / 32), kb = r / (D / 32);
                transpose_item(args.in[15] + (size_t)l * D * D, D, D, (bf16*)(wl + W2_OFF), nullptr, 64 * kb, 32 * nb, 32 * nb, scr, lane); continue; }
            r -= I2;
            if (r < I3) { const int nb = r % (DFF / 32), kb = r / (DFF / 32);
                transpose_item(args.in[17] + (size_t)l * D * DFF, D, DFF, (bf16*)(wl + W3_OFF), args.in[16] + l * D, 64 * kb, 32 * nb, 32 * nb, scr, lane); continue; }
            r -= I3;
            { const int nb = r % (D / 32), kb = r / (D / 32);
                transpose_item(args.in[18] + (size_t)l * DFF * D, DFF, D, (bf16*)(wl + W4_OFF), nullptr, 64 * kb, 32 * nb, 32 * nb, scr, lane); }
        }
        { bf16* WST = (bf16*)(ws + WS_WST); const float* aws = args.in[8];
          for (int i = bx * (NWAVES * 64) + tid; i < DEPTH * 8 * 128 * 128; i += G * NWAVES * 64) { const int s = i & 127, t = (i >> 7) & 127; WST[i] = (bf16)f2bf(s <= t ? aws[i] : 0.f); } }
        { float* SS0 = (float*)(ws + WS_SS);
          for (int m = gw; m < M; m += NGW) {
              const float* xr = m < MP ? x_prompt + (size_t)m * D : x_sample + (size_t)(m - MP) * D;
              f32x4 v[4]; float s = 0.f;
#pragma unroll
              for (int j = 0; j < 4; ++j) { v[j] = *(const f32x4*)(xr + 4 * lane + 256 * j); s += sumsq4(v[j]); }
              s = wave_sum(s);
#pragma unroll
              for (int j = 0; j < 4; ++j) *(u32x2*)(XB + (size_t)m * D + 4 * lane + 256 * j) = pack4(v[j]);
              if (lane < 16) SS0[(size_t)m * 16 + lane] = lane == 0 ? s : 0.f;
          } }
    }
    SEAM(0);

#pragma unroll 1
    for (int l = 0; l < DEPTH; ++l) {
        unsigned char* wl = ws + WS_W + (size_t)l * W_LAYER;
        float* SSa = (float*)(ws + WS_SS + (size_t)(2 * l) * SS_STRIDE);
        float* SSb = (float*)(ws + WS_SS + (size_t)(2 * l + 1) * SS_STRIDE);
        float* SSc = (float*)(ws + WS_SS + (size_t)(2 * l + 2) * SS_STRIDE);
        const int pb = 1 + 5 * l;
        if (IN(pb)) {
            pg8::Gemm g{XB, (const bf16*)(wl + W1_OFF), M, DIN, D}; pg8::StaticOrder S; S.init(M, DIN, G, bx);
            pg8::EpiG1 E{ZZ, SSa, out + O_CBP + (size_t)l * 8 * 30 * DB, out + O_CCP + (size_t)l * 8 * 2 * DC, out + O_CBS + (size_t)l * NSEQ_S * 30 * DB, out + O_CCS + (size_t)l * NSEQ_S * 2 * DC};
            pg8::gemm_phase<pg8::EpiG1, pg8::StaticOrder, true, true>(lds, g, S, E);
        }
        SEAM(pb);
        if (IN(pb + 1)) {
            MixArgs A;
            A.ZZ = ZZ; A.YC = YC; A.WST = (const bf16*)(ws + WS_WST) + (size_t)l * 8 * 128 * 128;
            A.ln_g = args.in[6] + l * DA; A.ln_b = args.in[7] + l * DA; A.a_bias = args.in[9] + l * 8 * 128; A.a_ws = args.in[8] + (size_t)l * 8 * 128 * 128;
            A.bw = args.in[10] + l * 31 * DB; A.bb = args.in[11] + l * DB; A.blg = args.in[12] + l * DB; A.blb = args.in[13] + l * DB; A.cw = args.in[14] + l * 3 * DC;
            A.st_b = args.in[2] + (size_t)l * NSEQ_S * 30 * DB; A.st_c = args.in[3] + (size_t)l * NSEQ_S * 2 * DC;
            A.o_cbs = out + O_CBS + (size_t)l * NSEQ_S * 30 * DB; A.o_v = out + O_V + (size_t)l * NSEQ_S * TS * DA;
#pragma unroll 1
            for (int u = bx; u < MP / 64 + MS / 64; u += G) {
                if (u < MP / 64) mixer_prompt_unit(lds, u, A, wave, lane);
                else mixer_sample_unit(u - MP / 64, A, wave, lane);
            }
        }
        SEAM(pb + 1);
        if (IN(pb + 2)) {
            pg8::Gemm g{YC, (const bf16*)(wl + W2_OFF), M, D, D}; pg8::StaticOrder S; S.init(M, D, G, bx);
            pg8::EpiRes E{l == 0 ? x_prompt : out, l == 0 ? x_sample : out + (size_t)MP * D, out, XB, SSb};
            pg8::gemm_phase<pg8::EpiRes, pg8::StaticOrder, true, true>(lds, g, S, E);
        }
        SEAM(pb + 2);
        if (IN(pb + 3)) {
            pg8::Gemm g{XB, (const bf16*)(wl + W3_OFF), M, DFF, D}; pg8::StaticOrder S; S.init(M, DFF, G, bx);
            pg8::EpiG3 E{HFF, SSb};
            pg8::gemm_phase<pg8::EpiG3, pg8::StaticOrder, true, true>(lds, g, S, E);
        }
        SEAM(pb + 3);
        if (IN(pb + 4)) {
            pg8::Gemm g{HFF, (const bf16*)(wl + W4_OFF), M, D, DFF}; pg8::StaticOrder S; S.init(M, D, G, bx);
            pg8::EpiRes E{out, out + (size_t)MP * D, out, XB, SSc};
            pg8::gemm_phase<pg8::EpiRes, pg8::StaticOrder, true, true>(lds, g, S, E);
        }
        SEAM(pb + 4);
    }
    if (IN(11)) {
        const float* gf = args.in[19];
        f32x4 gv[4];
#pragma unroll
        for (int j = 0; j < 4; ++j) gv[j] = *(const f32x4*)(gf + 4 * lane + 256 * j);
        for (int m = gw; m < M; m += NGW) {
            float* xr = out + (size_t)m * D; f32x4 v[4]; float s = 0.f;
#pragma unroll
            for (int j = 0; j < 4; ++j) { v[j] = *(const f32x4*)(xr + 4 * lane + 256 * j); s += sumsq4(v[j]); }
            const float rstd = __builtin_amdgcn_rsqf(wave_sum(s) * (1.0f / 1024.0f) + EPS);
#pragma unroll
            for (int j = 0; j < 4; ++j) *(f32x4*)(xr + 4 * lane + 256 * j) = v[j] * rstd * gv[j];
        }
    }
#undef IN
#undef SEAM
}

extern "C" void kernel_launch(void* const* d_in, const int* in_sizes, int n_in, void* d_out, int out_size, void* d_ws, size_t ws_size, hipStream_t stream) {
    static int grid = 0;
    if (grid == 0) {
        if (n_in != 20 || (size_t)out_size != O_END || ws_size < WS_END) { fprintf(stderr, "kernel_launch: unexpected shapes: n_in %d out %d ws %zu (need out %zu, ws >= %zu)\n", n_in, out_size, ws_size, (size_t)O_END, (size_t)WS_END); grid = -1; return; }
        int dev = 0, cus = 0, per_cu = 0;
        if (hipGetDevice(&dev) != hipSuccess || hipDeviceGetAttribute(&cus, hipDeviceAttributeMultiprocessorCount, dev) != hipSuccess) { grid = -1; return; }
        if (hipFuncSetAttribute((const void*)fwd_kernel, hipFuncAttributeMaxDynamicSharedMemorySize, LDS_BYTES) != hipSuccess) { fprintf(stderr, "kernel_launch: hipFuncSetAttribute failed\n"); grid = -1; return; }
        if (hipOccupancyMaxActiveBlocksPerMultiprocessor(&per_cu, (const void*)fwd_kernel, NWAVES * 64, LDS_BYTES) != hipSuccess || per_cu < 1) { fprintf(stderr, "kernel_launch: occupancy query says %d blocks per CU\n", per_cu); (void)hipGetLastError(); per_cu = 1; }
        grid = cus;
        fprintf(stderr, "kernel_launch: grid %d (cus %d, per_cu %d)\n", grid, cus, per_cu);
    }
    if (grid < 0) return;
    if (hipMemsetAsync((char*)d_ws + WS_CTL, 0, CTL_ZERO_BYTES, stream) != hipSuccess) return;
    Args a{};
    for (int i = 0; i < 20; ++i) a.in[i] = (const float*)d_in[i];
    a.out = (float*)d_out; a.ws = (unsigned char*)d_ws;
    for (int li = 0; li < N_LAUNCHES; ++li) {
        a.ph_lo = (N_LAUNCHES == 1) ? 0 : li; a.ph_hi = (N_LAUNCHES == 1) ? NPH : li + 1; a.li = li;
        hipLaunchKernelGGL(fwd_kernel, dim3(grid), dim3(NWAVES * 64), LDS_BYTES, stream, a);
        const hipError_t le = hipPeekAtLastError();
        if (le != hipSuccess) { fprintf(stderr, "kernel_launch: launch %d failed: %s\n", li, hipGetErrorName(le)); break; }
    }
}
```

```cpp
#include <hip/hip_runtime.h>
#include <cstdio>
#include <cstdint>
namespace pg8 {
#define PG8_LAS __attribute__((address_space(3)))
typedef unsigned short bf16_t;
typedef short bf16x8 __attribute__((ext_vector_type(8)));
typedef float f32x4 __attribute__((ext_vector_type(4)));
typedef unsigned u32x4 __attribute__((ext_vector_type(4)));
constexpr int BM = 256, BK = 64, HALF = 128, HTB = HALF * BK * 2  , STAGE_BYTES = 8 * HTB, NXCD = 8, WGM = 8;

__host__ __device__ __forceinline__ int lds_byte(int r, int c) { const int st = (r >> 4) * 2 + (c >> 5), rr = r & 15, cc = c & 31, ob = rr * 64 + cc * 2; return st * 1024 + (ob ^ (((ob >> 9) & 1) << 5)); }
__host__ __device__ __forceinline__ void stage_rc(int b, int& R, int& C) { const int st = b / 1024, sb = b % 1024, swz = sb ^ (((sb >> 9) & 1) << 5); R = (st >> 1) * 16 + swz / 64; C = (st & 1) * 32 + (swz % 64) / 2; }
__host__ __device__ __forceinline__ int perm32(int rho) { const int n = rho >> 4, i = rho & 15; return 8 * (i >> 2) + 4 * n + (i & 3); }

struct Unit { int pm, pn; };
struct Gemm { const bf16_t* A; const bf16_t* Bt; int M, N, K; };

struct StaticOrder {
    int nM, nN, nwg, G, c;
    __host__ __device__ void init(int M, int N, int G_, int c_) { nM = M / BM; nN = N / BM; nwg = nM * nN; G = G_; c = c_; }
    __host__ __device__ bool next(int i, Unit& u) const {
        const long L = (long)i * G + c; if (L >= nwg) return false;
        int wgid = (int)L; { const int q = nwg / NXCD, r = nwg % NXCD, xcd = wgid % NXCD, off = wgid / NXCD; wgid = (xcd < r ? xcd * (q + 1) : r * (q + 1) + (xcd - r) * q) + off; }
        const int nig = WGM * nN, gid = wgid / nig, fm = gid * WGM, gsz = (nM - fm) < WGM ? (nM - fm) : WGM;
        u.pm = fm + ((wgid % nig) % gsz); u.pn = (wgid % nig) / gsz; return true;
    }
    __device__ __forceinline__ void a_ready(const Unit&) const {}
    __device__ __forceinline__ void done(const Unit&) const {}
};

__device__ __forceinline__ unsigned cvt_pk_bf16(float lo, float hi) { unsigned r; asm volatile("v_cvt_pk_bf16_f32 %0, %1, %2" : "=v"(r) : "v"(lo), "v"(hi)); return r; }
typedef float f32x2 __attribute__((ext_vector_type(2)));
constexpr int MP_ROWS = 16384;
constexpr float RMS_EPS = 1e-6f;
__device__ __forceinline__ float fast_sigmoid(float x) { return __builtin_amdgcn_rcpf(1.0f + __builtin_amdgcn_exp2f(-1.4426950408889634f * x)); }
__device__ __forceinline__ float gelu_tanh(float x) {
    const float c1 = -2.0f * 0.7978845608028654f * 1.4426950408889634f, c2 = c1 * 0.044715f;
    const float x2 = x * x, e = __builtin_amdgcn_exp2f(x * (c1 + c2 * x2));
    return x * __builtin_amdgcn_rcpf(1.0f + e);
}
__device__ __forceinline__ void load_rstd(float (&rs)[2][4], const float* SS, int row0, int fq) {
#pragma unroll
    for (int ai = 0; ai < 2; ++ai)
#pragma unroll
        for (int m = 0; m < 4; ++m) {
            const f32x4 p = *(const f32x4*)(SS + (size_t)(row0 + ai * HALF + m * 16) * 16 + 4 * fq);
            float s = (p[0] + p[1]) + (p[2] + p[3]);
            s += __shfl_xor(s, 16); s += __shfl_xor(s, 32);
            rs[ai][m] = __builtin_amdgcn_rsqf(s * (1.0f / 1024.0f) + RMS_EPS);
        }
}
__device__ __forceinline__ u32x4 pack8(const f32x4 a, const f32x4 b) { u32x4 w; w.x = cvt_pk_bf16(a[0], a[1]); w.y = cvt_pk_bf16(a[2], a[3]); w.z = cvt_pk_bf16(b[0], b[1]); w.w = cvt_pk_bf16(b[2], b[3]); return w; }

struct EpiG1 {
    static constexpr bool PERM = true, AFTER_DRAIN = false;
    bf16_t* ZZ; const float* SS; float* cbp; float* ccp; float* cbs; float* ccs;
    float* LNS;
    __device__ __forceinline__ void operator()(const f32x4 (&acc)[2][2][4][2], const Unit& u, int wr, int wc, int fr, int fq) const {
        const int row0 = u.pm * BM + wr * 64 + fr, pn = u.pn;
        float rs[2][4]; load_rstd(rs, SS, row0, fq);
        if (pn < 4) {
#pragma unroll
            for (int ai = 0; ai < 2; ++ai)
#pragma unroll
                for (int m = 0; m < 4; ++m) { const int row = row0 + ai * HALF + m * 16; bf16_t* rowp = ZZ + (size_t)row * 1792 + pn * 256 + wc * 32 + 8 * fq; const float r = rs[ai][m];
                    float ls = 0.f, lq = 0.f;
#pragma unroll
                    for (int bj = 0; bj < 2; ++bj) { f32x4 v0 = acc[ai][bj][m][0] * r, v1 = acc[ai][bj][m][1] * r;
#pragma unroll
                        for (int i = 0; i < 4; ++i) { v0[i] = gelu_tanh(v0[i]); v1[i] = gelu_tanh(v1[i]); }
                        ls += ((v0[0] + v0[1]) + (v0[2] + v0[3])) + ((v1[0] + v1[1]) + (v1[2] + v1[3]));
                        lq += ((v0[0] * v0[0] + v0[1] * v0[1]) + (v0[2] * v0[2] + v0[3] * v0[3])) + ((v1[0] * v1[0] + v1[1] * v1[1]) + (v1[2] * v1[2] + v1[3] * v1[3]));
                        *(u32x4*)(rowp + bj * HALF) = pack8(v0, v1); }
                    if (pn >= 2) { ls += __shfl_xor(ls, 16); ls += __shfl_xor(ls, 32); lq += __shfl_xor(lq, 16); lq += __shfl_xor(lq, 32);
                        if (fq == 0) *(f32x2*)(LNS + ((size_t)row * 8 + (pn - 2) * 4 + wc) * 2) = (f32x2){ls, lq}; } }
        } else if (pn < 8) {
            const bool isB = pn < 6; const int half = pn & 1, ch = 128 * half + wc * 32 + 8 * fq, colbase = (isB ? 1024 : 1280) + ch;
#pragma unroll
            for (int ai = 0; ai < 2; ++ai)
#pragma unroll
                for (int m = 0; m < 4; ++m) { const int row = row0 + ai * HALF + m * 16; const float r = rs[ai][m];
                    f32x4 a0 = acc[ai][0][m][0] * r, a1 = acc[ai][0][m][1] * r, g0 = acc[ai][1][m][0] * r, g1 = acc[ai][1][m][1] * r;
                    if (isB) {
#pragma unroll
                        for (int i = 0; i < 4; ++i) { a0[i] *= fast_sigmoid(g0[i]); a1[i] *= fast_sigmoid(g1[i]); }
                    } else { a0 = a0 * g0; a1 = a1 * g1; }
                    *(u32x4*)(ZZ + (size_t)row * 1792 + colbase) = pack8(a0, a1);
                    float* dst = nullptr;
                    if (row < MP_ROWS) { const int t = row & 2047, b = row >> 11;
                        if (isB) { if (t >= 2018) dst = cbp + (size_t)(b * 30 + (t - 2018)) * 256 + ch; }
                        else     { if (t >= 2046) dst = ccp + (size_t)(b * 2 + (t - 2046)) * 256 + ch; }
                    } else { const int q = row - MP_ROWS, n = q >> 3, t = q & 7;
                        if (isB) dst = cbs + (size_t)(n * 30 + 22 + t) * 256 + ch;
                        else if (t >= 6) dst = ccs + (size_t)(n * 2 + (t - 6)) * 256 + ch;
                    }
                    if (dst) { *(f32x4*)dst = a0; *(f32x4*)(dst + 4) = a1; }
                }
        } else {
#pragma unroll
            for (int ai = 0; ai < 2; ++ai)
#pragma unroll
                for (int m = 0; m < 4; ++m) { bf16_t* rowp = ZZ + (size_t)(row0 + ai * HALF + m * 16) * 1792 + 1536 + wc * 32 + 8 * fq; const float r = rs[ai][m];
#pragma unroll
                    for (int bj = 0; bj < 2; ++bj) *(u32x4*)(rowp + bj * HALF) = pack8(acc[ai][bj][m][0] * r, acc[ai][bj][m][1] * r); }
        }
    }
};
struct EpiG3 {
    static constexpr bool PERM = true, AFTER_DRAIN = false;
    bf16_t* H; const float* SS;
    __device__ __forceinline__ void operator()(const f32x4 (&acc)[2][2][4][2], const Unit& u, int wr, int wc, int fr, int fq) const {
        const int row0 = u.pm * BM + wr * 64 + fr;
        float rs[2][4]; load_rstd(rs, SS, row0, fq);
#pragma unroll
        for (int ai = 0; ai < 2; ++ai)
#pragma unroll
            for (int m = 0; m < 4; ++m) { bf16_t* rowp = H + (size_t)(row0 + ai * HALF + m * 16) * 4096 + u.pn * BM + wc * 32 + 8 * fq; const float r = rs[ai][m];
#pragma unroll
                for (int bj = 0; bj < 2; ++bj) { f32x4 v0 = acc[ai][bj][m][0] * r, v1 = acc[ai][bj][m][1] * r;
#pragma unroll
                    for (int i = 0; i < 4; ++i) { const float a = fmaxf(v0[i], 0.f), b = fmaxf(v1[i], 0.f); v0[i] = a * a; v1[i] = b * b; }
                    *(u32x4*)(rowp + bj * HALF) = pack8(v0, v1); } }
    }
};
struct EpiRes {
    static constexpr bool PERM = false, AFTER_DRAIN = false;
    const float* xin_p; const float* xin_s;
    float* xout; bf16_t* XB; float* SSo;
    __device__ __forceinline__ void operator()(const f32x4 (&acc)[2][2][4][2], const Unit& u, int wr, int wc, int fr, int fq) const {
        typedef unsigned u32x2v __attribute__((ext_vector_type(2)));
        const int row0 = u.pm * BM + wr * 64 + fr, col0 = u.pn * BM + wc * 32 + 4 * fq;
#pragma unroll
        for (int ai = 0; ai < 2; ++ai)
#pragma unroll
            for (int m = 0; m < 4; ++m) { const int row = row0 + ai * HALF + m * 16;
                const float* xi = (u.pm < 64 ? xin_p + (size_t)row * 1024 : xin_s + (size_t)(row - MP_ROWS) * 1024) + col0;
                float* xo = xout + (size_t)row * 1024 + col0; bf16_t* xb = XB + (size_t)row * 1024 + col0; float q = 0.f;
#pragma unroll
                for (int bj = 0; bj < 2; ++bj)
#pragma unroll
                    for (int n = 0; n < 2; ++n) { const f32x4 x = *(const f32x4*)(xi + bj * HALF + n * 16) + acc[ai][bj][m][n];
                        *(f32x4*)(xo + bj * HALF + n * 16) = x; q += (x[0] * x[0] + x[1] * x[1]) + (x[2] * x[2] + x[3] * x[3]);
                        u32x2v w; w.x = cvt_pk_bf16(x[0], x[1]); w.y = cvt_pk_bf16(x[2], x[3]); *(u32x2v*)(xb + bj * HALF + n * 16) = w; }
                q += __shfl_xor(q, 16); q += __shfl_xor(q, 32);
                if (fq == 0) SSo[(size_t)row * 16 + u.pn * 4 + wc] = q;
                if (m & 1) asm volatile("" ::: "memory");
            }
    }
};

template <class Epi, class Sched, bool ALIGN_EPI = false, bool SP2 = false>
__device__ __forceinline__ void gemm_phase(PG8_LAS unsigned char* lds, const Gemm g, const Sched& S, const Epi& E) {
    int tid_ = threadIdx.x; asm volatile("" : "+v"(tid_));
    const int tid = tid_, wid = __builtin_amdgcn_readfirstlane(tid >> 6), lane = tid & 63, wr = wid >> 2, wc = wid & 3, fr = lane & 15, fq = lane >> 4;
    const int K = g.K, nt = K / BK;
    unsigned voffA[2], voffB[2];
#pragma unroll
    for (int i = 0; i < 2; ++i) { int R, C; stage_rc(tid * 16 + i * 8192, R, C); const int Rb = Epi::PERM ? ((R & ~31) + perm32(R & 31)) : R;
        voffA[i] = (unsigned)(R * K + C) * 2u; voffB[i] = (unsigned)(Rb * K + C) * 2u; }
    const size_t kstep = (size_t)(BK * 2);
    const size_t hstep = (size_t)HALF * K * 2;
    const size_t tstep = 2 * hstep;
    const unsigned ldsw = (unsigned)wid * 1024u;
    const int aoff = lds_byte(wr * 64 + fr, fq * 8), boff = lds_byte(wc * 32 + fr, fq * 8);
#define PG8_SA(b, h) (((b) * 2 + (h)) * HTB)
#define PG8_SB(b, h) ((4 + (b) * 2 + (h)) * HTB)
#define PG8_STAGE(bufoff, gbase, voff) do { _Pragma("unroll") for (int _i = 0; _i < 2; ++_i) \
        __builtin_amdgcn_global_load_lds((const unsigned*)((const char*)(gbase) + (voff)[_i]), (PG8_LAS unsigned*)(lds + (bufoff) + ldsw + _i * 8192), 16, 0, 0); } while (0)
#define PG8_LDA(dst, b, h) do { _Pragma("unroll") for (int m = 0; m < 4; ++m) _Pragma("unroll") for (int k = 0; k < 2; ++k) dst[m][k] = *(const PG8_LAS bf16x8*)(lds + PG8_SA(b, h) + aoff + m * 2048 + k * 1024); } while (0)
#define PG8_LDB(dst, b, h) do { _Pragma("unroll") for (int n = 0; n < 2; ++n) _Pragma("unroll") for (int k = 0; k < 2; ++k) dst[n][k] = *(const PG8_LAS bf16x8*)(lds + PG8_SB(b, h) + boff + n * 2048 + k * 1024); } while (0)
#define PG8_MMA(ai, bj, At, Bt) do { __builtin_amdgcn_s_setprio(1); _Pragma("unroll") for (int m = 0; m < 4; ++m) _Pragma("unroll") for (int n = 0; n < 2; ++n) _Pragma("unroll") for (int k = 0; k < 2; ++k) \
        acc[ai][bj][m][n] = __builtin_amdgcn_mfma_f32_16x16x32_bf16(Bt[n][k], At[m][k], acc[ai][bj][m][n], 0, 0, 0); __builtin_amdgcn_s_setprio(0); } while (0)
#define PG8_WAIT_V(n) asm volatile("s_waitcnt vmcnt(" #n ")" ::: "memory")
#define PG8_WAIT_L(n) asm volatile("s_waitcnt lgkmcnt(" #n ")" ::: "memory")
#define PG8_BAR __builtin_amdgcn_s_barrier()
#define PG8_SCHED __builtin_amdgcn_sched_barrier(0)
    Unit cur, nxt; int ui = 0;
    if (!S.next(0, cur)) return;
    f32x4 acc[2][2][4][2];
#pragma unroll
    for (int a = 0; a < 2; ++a)
#pragma unroll
        for (int b = 0; b < 2; ++b)
#pragma unroll
            for (int m = 0; m < 4; ++m)
#pragma unroll
                for (int n = 0; n < 2; ++n) acc[a][b][m][n] = (f32x4){0.f, 0.f, 0.f, 0.f};
    bf16x8 At[4][2], B0[2][2], B1[2][2];
    const char* cA = (const char*)g.A + (size_t)cur.pm * tstep; const char* cB = (const char*)g.Bt + (size_t)cur.pn * tstep;
    S.a_ready(cur);
    if constexpr (SP2) {
        PG8_STAGE(PG8_SB(0, 0), cB, voffB); PG8_STAGE(PG8_SB(0, 1), cB + hstep, voffB); PG8_STAGE(PG8_SA(0, 0), cA, voffA); PG8_STAGE(PG8_SA(0, 1), cA + hstep, voffA);
        if (wr == 1) PG8_BAR;
        PG8_WAIT_V(2); PG8_BAR;
        PG8_STAGE(PG8_SB(1, 0), cB + kstep, voffB); PG8_STAGE(PG8_SA(1, 0), cA + kstep, voffA); PG8_STAGE(PG8_SB(1, 1), cB + hstep + kstep, voffB);
        PG8_WAIT_V(6); PG8_BAR;
    } else {
        PG8_STAGE(PG8_SB(0, 0), cB, voffB); PG8_STAGE(PG8_SA(0, 0), cA, voffA); PG8_STAGE(PG8_SB(0, 1), cB + hstep, voffB); PG8_STAGE(PG8_SA(0, 1), cA + hstep, voffA);
        if (wr == 1) PG8_BAR;
        PG8_WAIT_V(4); PG8_BAR;
        PG8_STAGE(PG8_SB(1, 0), cB + kstep, voffB); PG8_STAGE(PG8_SA(1, 0), cA + kstep, voffA); PG8_STAGE(PG8_SB(1, 1), cB + hstep + kstep, voffB);
        PG8_WAIT_V(6); PG8_BAR;
    }
    for (;;) {
        const bool has_next = S.next(ui + 1, nxt);
        const char* nA = has_next ? (const char*)g.A + (size_t)nxt.pm * tstep : cA; const char* nB = has_next ? (const char*)g.Bt + (size_t)nxt.pn * tstep : cB;
        for (int t = 0; t < nt; t += 2) {
            const bool last = (t == nt - 2);
            const char* a1 = cA + (size_t)(t + 1) * kstep;
            const char* a2 = last ? nA : cA + (size_t)(t + 2) * kstep; const char* b2 = last ? nB : cB + (size_t)(t + 2) * kstep;
            const char* a3 = a2 + kstep; const char* b3 = b2 + kstep;
            if (last && has_next) S.a_ready(nxt);
            if constexpr (SP2) {
            PG8_LDB(B0, 0, 0); PG8_LDB(B1, 0, 1); PG8_SCHED; PG8_LDA(At, 0, 0); PG8_STAGE(PG8_SA(1, 1), a1 + hstep, voffA);
            PG8_WAIT_V(8); PG8_WAIT_L(0); PG8_BAR; PG8_MMA(0, 0, At, B0); PG8_MMA(0, 1, At, B1); PG8_BAR; PG8_SCHED;
            PG8_LDA(At, 0, 1); PG8_STAGE(PG8_SB(0, 0), b2, voffB); PG8_STAGE(PG8_SB(0, 1), b2 + hstep, voffB); PG8_STAGE(PG8_SA(0, 0), a2, voffA);
            PG8_WAIT_V(8); PG8_WAIT_L(0); PG8_BAR; PG8_MMA(1, 0, At, B0); PG8_MMA(1, 1, At, B1); PG8_BAR; PG8_SCHED;
            PG8_LDB(B0, 1, 0); PG8_LDB(B1, 1, 1); PG8_SCHED; PG8_LDA(At, 1, 0); PG8_STAGE(PG8_SA(0, 1), a2 + hstep, voffA);
            PG8_WAIT_V(8); PG8_WAIT_L(0); PG8_BAR; PG8_MMA(0, 0, At, B0); PG8_MMA(0, 1, At, B1); PG8_BAR; PG8_SCHED;
            PG8_LDA(At, 1, 1); PG8_STAGE(PG8_SB(1, 0), b3, voffB); PG8_STAGE(PG8_SB(1, 1), b3 + hstep, voffB); PG8_STAGE(PG8_SA(1, 0), a3, voffA);
            PG8_WAIT_V(8); PG8_WAIT_L(0); PG8_BAR; PG8_MMA(1, 0, At, B0); PG8_MMA(1, 1, At, B1); PG8_BAR; PG8_SCHED;
            } else {
            PG8_LDB(B0, 0, 0); PG8_SCHED; PG8_LDA(At, 0, 0); PG8_STAGE(PG8_SA(1, 1), a1 + hstep, voffA);
            PG8_WAIT_L(8); PG8_BAR; PG8_WAIT_L(0); PG8_MMA(0, 0, At, B0); PG8_BAR; PG8_SCHED;
            PG8_LDB(B1, 0, 1); PG8_STAGE(PG8_SB(0, 0), b2, voffB);
            PG8_BAR; PG8_WAIT_L(0); PG8_MMA(0, 1, At, B1); PG8_BAR;
            PG8_LDA(At, 0, 1); PG8_STAGE(PG8_SA(0, 0), a2, voffA);
            PG8_BAR; PG8_WAIT_L(0); PG8_MMA(1, 0, At, B0); PG8_BAR; PG8_SCHED;
            PG8_STAGE(PG8_SB(0, 1), b2 + hstep, voffB);
            PG8_WAIT_V(6); PG8_BAR; PG8_MMA(1, 1, At, B1); PG8_BAR;
            PG8_LDB(B0, 1, 0); PG8_SCHED; PG8_LDA(At, 1, 0); PG8_STAGE(PG8_SA(0, 1), a2 + hstep, voffA);
            PG8_WAIT_L(8); PG8_BAR; PG8_WAIT_L(0); PG8_MMA(0, 0, At, B0); PG8_BAR; PG8_SCHED;
            PG8_LDB(B1, 1, 1); PG8_STAGE(PG8_SB(1, 0), b3, voffB);
            PG8_BAR; PG8_WAIT_L(0); PG8_MMA(0, 1, At, B1); PG8_BAR;
            PG8_LDA(At, 1, 1); PG8_STAGE(PG8_SA(1, 0), a3, voffA);
            PG8_BAR; PG8_WAIT_L(0); PG8_MMA(1, 0, At, B0); PG8_BAR; PG8_SCHED;
            PG8_STAGE(PG8_SB(1, 1), b3 + hstep, voffB);
            PG8_WAIT_V(6); PG8_BAR; PG8_MMA(1, 1, At, B1); PG8_BAR;
            }
        }
        if constexpr (ALIGN_EPI) { if (wr == 0) PG8_BAR; }
        if constexpr (!Epi::AFTER_DRAIN) { E(acc, cur, wr, wc, fr, fq); S.done(cur); }
        if (!has_next) break;
#pragma unroll
        for (int a = 0; a < 2; ++a)
#pragma unroll
            for (int b = 0; b < 2; ++b)
#pragma unroll
                for (int m = 0; m < 4; ++m)
#pragma unroll
                    for (int n = 0; n < 2; ++n) acc[a][b][m][n] = (f32x4){0.f, 0.f, 0.f, 0.f};
        cur = nxt; cA = nA; cB = nB; ++ui;
        if constexpr (ALIGN_EPI) { if (wr == 1) PG8_BAR; }
    }
    PG8_WAIT_V(0);
    if constexpr (!ALIGN_EPI) { if (wr == 0) PG8_BAR; }
    PG8_BAR;
    if constexpr (Epi::AFTER_DRAIN) { E.fused(acc, cur, wr, wc, fr, fq, lds, wid, lane); S.done(cur); }
#undef PG8_SA
#undef PG8_SB
#undef PG8_STAGE
#undef PG8_LDA
#undef PG8_LDB
#undef PG8_MMA
#undef PG8_WAIT_V
#undef PG8_WAIT_L
#undef PG8_BAR
#undef PG8_SCHED
}
}
#define GAS __attribute__((address_space(1)))
#define LAS __attribute__((address_space(3)))
typedef unsigned short bf16;
typedef unsigned v4u __attribute__((ext_vector_type(4)));
typedef float f32x4 __attribute__((ext_vector_type(4)));
typedef short bf16x8 __attribute__((ext_vector_type(8)));
typedef GAS unsigned gu32;
typedef GAS unsigned long long gu64;
#define RLX_AGENT __ATOMIC_RELAXED, __HIP_MEMORY_SCOPE_AGENT
#define LDS_WAIT() asm volatile("s_waitcnt lgkmcnt(0)" ::: "memory")
#define VM_WAIT() asm volatile("s_waitcnt vmcnt(0)" ::: "memory")
__device__ __forceinline__ unsigned long long rt() { return __builtin_amdgcn_s_memrealtime(); }
__device__ __forceinline__ unsigned f2bf(float f) { unsigned u = __builtin_bit_cast(unsigned, f); return (u + 0x7fffu + ((u >> 16) & 1u)) >> 16; }
__device__ __forceinline__ unsigned pk2(float lo, float hi) { return f2bf(lo) | (f2bf(hi) << 16); }

#define XB_TMO      128
#define XB_XCNT(j)  (256  + 64 * (j))
#define XB_XSUB(j)  (1280 + 64 * (j))
#define XB_XGEN(j)  (2304 + 64 * (j))
#define XB_TOP      3328
#define XB_TOPGEN   3392
#define XCD_BAR_WORDS 3456
#define XB_SPIN_CAP (1u << 18)

__device__ __forceinline__ unsigned xb_ld(unsigned* p)              { return __hip_atomic_load(p, __ATOMIC_RELAXED, __HIP_MEMORY_SCOPE_AGENT); }
__device__ __forceinline__ unsigned xb_add(unsigned* p, unsigned v) { return __hip_atomic_fetch_add(p, v, __ATOMIC_RELAXED, __HIP_MEMORY_SCOPE_AGENT); }
__device__ __forceinline__ unsigned xb_xcc_id() { return (unsigned)__builtin_amdgcn_s_getreg((3 << 11) | 20) & 0xFu; }
#define XB_SPIN(cond, bar) do { unsigned _sp = 0; while (cond) { __builtin_amdgcn_s_sleep(1); \
    if ((++_sp & 255u) == 0u) { if (xb_ld(&(bar)[XB_TMO])) break; if (_sp > XB_SPIN_CAP) { atomicAdd(&(bar)[XB_TMO], 1u); break; } } } } while (0)

struct XcdBarrier {
    unsigned* bar; unsigned x;
    volatile LAS unsigned* st;
};

__device__ __forceinline__ XcdBarrier xcd_barrier_post(unsigned* bar, volatile LAS unsigned* st) {
    XcdBarrier b; b.bar = bar; b.x = xb_xcc_id(); b.st = st;
    if (threadIdx.x == 0) (void)xb_add(&bar[XB_XCNT(b.x)], 1u);
    return b;
}
__device__ __forceinline__ void xcd_barrier_complete(unsigned* bar, unsigned x, unsigned& nloc, unsigned& nx) {
    const unsigned G = gridDim.x * gridDim.y * gridDim.z;
    unsigned sum, cnt, mine, sp = 0u;
    for (;;) {
        sum = 0u; cnt = 0u; mine = 0u;
#pragma unroll
        for (unsigned j = 0; j < 16; ++j) { const unsigned c = xb_ld(&bar[XB_XCNT(j)]); sum += c; cnt += (c > 0u) ? 1u : 0u; mine = (j == x) ? c : mine; }
        if (sum == G) break;
        __builtin_amdgcn_s_sleep(1);
        if ((++sp & 255u) == 0u) { if (xb_ld(&bar[XB_TMO])) break; if (sp > XB_SPIN_CAP) { atomicAdd(&bar[XB_TMO], 1u); break; } }
    }
    nloc = mine > 0u ? mine : 1u; nx = cnt > 0u ? cnt : 1u;
}

__device__ __forceinline__ void xcd_barrier(const XcdBarrier& b) {
    asm volatile("s_waitcnt vmcnt(0)" ::: "memory");
    __syncthreads();
    if (threadIdx.x == 0) {
        unsigned* bar = b.bar;
        __builtin_amdgcn_s_waitcnt(0);
        unsigned nloc = b.st[0], nx = b.st[1];
        if (nloc == 0u) { xcd_barrier_complete(bar, b.x, nloc, nx); b.st[0] = nloc; b.st[1] = nx; }
        const unsigned old = xb_add(&bar[XB_XSUB(b.x)], 1u);
        const unsigned gen = old / nloc;
        if (old + 1u == (gen + 1u) * nloc) {
            __builtin_amdgcn_fence(__ATOMIC_RELEASE, "agent");
            asm volatile("s_waitcnt vmcnt(0)" ::: "memory");
            const unsigned og = xb_add(&bar[XB_TOP], 1u);
            const unsigned tg = og / nx;
            if (og + 1u == (tg + 1u) * nx) xb_add(&bar[XB_TOPGEN], 1u);
            else XB_SPIN(xb_ld(&bar[XB_TOPGEN]) == tg, bar);
            __builtin_amdgcn_fence(__ATOMIC_ACQUIRE, "agent");
            xb_add(&bar[XB_XGEN(b.x)], 1u);
            asm volatile("s_waitcnt vmcnt(0)" ::: "memory");
        } else {
            XB_SPIN(xb_ld(&bar[XB_XGEN(b.x)]) == gen, bar);
            __builtin_amdgcn_fence(__ATOMIC_ACQUIRE, "agent");
            asm volatile("s_waitcnt vmcnt(0)" ::: "memory");
        }
    }
    __syncthreads();
}

#ifndef MK_N_LAUNCHES
#define MK_N_LAUNCHES 1
#endif
constexpr int NWAVES = 8;
constexpr int NPH = 12;
constexpr int N_LAUNCHES = MK_N_LAUNCHES;
constexpr int D = 1024, DIN = 2304, DFF = 4096, DA = 512, DB = 256, DC = 256, DEPTH = 2;
constexpr int MP = 16384, MS = 1024, M = MP + MS, SEQ = 2048, NSEQ_S = 128, TS = 8;
constexpr int ZP = 1792;
constexpr float EPS = 1e-6f;
constexpr size_t O_Y = 0, O_CBP = (size_t)M * D, O_CCP = O_CBP + (size_t)DEPTH * 8 * 30 * DB, O_CBS = O_CCP + (size_t)DEPTH * 8 * 2 * DC,
                 O_CCS = O_CBS + (size_t)DEPTH * NSEQ_S * 30 * DB, O_V = O_CCS + (size_t)DEPTH * NSEQ_S * 2 * DC, O_END = O_V + (size_t)DEPTH * NSEQ_S * TS * DA;
constexpr size_t MiB = 1u << 20;
constexpr size_t WS_CTL = 0, CTL_ZERO_BYTES = 1 * MiB;
constexpr size_t WS_W = 2 * MiB, W_LAYER = 22 * MiB + MiB / 2, W1_OFF = 0, W2_OFF = 4 * MiB + MiB / 2, W3_OFF = 6 * MiB + MiB / 2, W4_OFF = 14 * MiB + MiB / 2;
constexpr size_t WS_WST = 47 * MiB;
constexpr size_t WS_WSS = 47 * MiB + MiB / 2;
constexpr size_t WS_SS = 48 * MiB, SS_STRIDE = MiB + MiB / 4;
constexpr size_t WS_LNS = 54 * MiB + MiB / 2;
constexpr size_t WS_XB = 56 * MiB;
constexpr size_t WS_ZZ = 90 * MiB;
constexpr size_t WS_YC = 150 * MiB;
constexpr size_t WS_HFF = 90 * MiB;
constexpr size_t WS_END = 226 * MiB;
static_assert(WS_W + 2 * W_LAYER <= WS_WST && WS_SS + 5 * SS_STRIDE <= WS_LNS && WS_LNS + (size_t)M * 64 <= WS_XB && WS_XB + (size_t)M * D * 2 <= WS_ZZ && WS_ZZ + (size_t)M * ZP * 2 <= WS_YC && WS_YC + (size_t)M * D * 2 <= WS_END && WS_HFF + (size_t)M * DFF * 2 <= WS_END, "ws map");
constexpr int CW_BAR = 4096;
constexpr int RING_BYTES = 135168;
constexpr int LDSCTL_OFF = RING_BYTES, MISC_OFF = LDSCTL_OFF + 320;
constexpr int LDS_BYTES = 147456;
constexpr int VI_PITCH = 1032, LDS_STATS_OFF = 128 * VI_PITCH;
typedef float f32x2v __attribute__((ext_vector_type(2)));
static_assert(128 * VI_PITCH + 1024 <= RING_BYTES && MISC_OFF + 128 <= LDS_BYTES, "LDS map");

typedef unsigned u32x2 __attribute__((ext_vector_type(2)));
using pg8::cvt_pk_bf16;
__device__ __forceinline__ f32x4 unpack4(u32x2 p) { f32x4 r; r[0] = __uint_as_float(p.x << 16); r[1] = __uint_as_float(p.x & 0xffff0000u); r[2] = __uint_as_float(p.y << 16); r[3] = __uint_as_float(p.y & 0xffff0000u); return r; }
__device__ __forceinline__ u32x2 pack4(f32x4 v) { u32x2 r; r.x = cvt_pk_bf16(v[0], v[1]); r.y = cvt_pk_bf16(v[2], v[3]); return r; }
__device__ __forceinline__ float wave_sum(float v) {
#pragma unroll
    for (int o = 1; o < 64; o <<= 1) v += __shfl_xor(v, o);
    return v;
}
__device__ __forceinline__ float sum4(f32x4 v) { return (v[0] + v[1]) + (v[2] + v[3]); }
__device__ __forceinline__ float sumsq4(f32x4 v) { return (v[0] * v[0] + v[1] * v[1]) + (v[2] * v[2] + v[3] * v[3]); }

struct Args { const float* in[20]; float* out; unsigned char* ws; int ph_lo, ph_hi, li, pad; };

__device__ __forceinline__ void transpose_item(const float* W, int K, int N, bf16* WT, const float* g, int k0, int ns0, int nd0, LAS float* scr, int lane) {
#pragma unroll 8
    for (int i = 0; i < 32; ++i) { const int kk = 2 * i + (lane >> 5); float v = W[(size_t)(k0 + kk) * N + ns0 + (lane & 31)]; if (g) v *= g[k0 + kk]; scr[kk * 33 + (lane & 31)] = v; }
    LDS_WAIT(); asm volatile("" ::: "memory");
    const int c = lane & 7;
#pragma unroll
    for (int j = 0; j < 4; ++j) { const int n = (lane >> 3) + 8 * j; const LAS float* s = scr + (8 * c) * 33 + n;
        v4u o; o.x = pk2(s[0 * 33], s[1 * 33]); o.y = pk2(s[2 * 33], s[3 * 33]); o.z = pk2(s[4 * 33], s[5 * 33]); o.w = pk2(s[6 * 33], s[7 * 33]);
        *(GAS v4u*)(WT + (size_t)(nd0 + n) * K + k0 + 8 * c) = o; }
    LDS_WAIT(); asm volatile("" ::: "memory");
}
__device__ __forceinline__ int win_src_col(int np) {
    const int t = np >> 8, j = np & 255;
    if (t < 4) return np;
    if (t < 6) return (j < 128 ? 1024 : 1280) + 128 * (t - 4) + (j & 127);
    if (t < 8) return (j < 128 ? 1792 : 2048) + 128 * (t - 6) + (j & 127);
    return 1536 + j;
}

#ifndef PROBE_PRE
#define PROBE_PRE 0
#define PROBE_STRIP 0
#endif
struct MixArgs {
    const bf16* ZZ; bf16* YC; const bf16* WST; const bf16* WSS;
    const float* LNS;
    const float *ln_g, *ln_b, *a_bias, *bw, *bb, *blg, *blb, *cw;
    const float *st_b, *st_c;
    float *o_cbs, *o_v;
};
constexpr int NA_P = MP / 64, NA_S = MS / 64, NBC_P = MP / 64, NBC_S = NSEQ_S / 4, N_MIX_UNITS = NA_P + NBC_P + NA_S + NBC_S;
constexpr int LDS_WB = 0, LDS_WC = 152 * 512, LDS_WW = LDS_WC + 66 * 512;
static_assert(LDS_WW + 31 * 512 <= RING_BYTES, "LDS map (BC unit)");
__device__ __forceinline__ void ln_stats_row(const float* LNS, int row, float& mu, float& rstd) {
    const f32x4* p = (const f32x4*)(LNS + (size_t)row * 16);
    const f32x4 a = p[0], b = p[1], c = p[2], d = p[3];
    const float s = ((a[0] + a[2]) + (b[0] + b[2])) + ((c[0] + c[2]) + (d[0] + d[2]));
    const float q = ((a[1] + a[3]) + (b[1] + b[3])) + ((c[1] + c[3]) + (d[1] + d[3]));
    mu = s * (1.0f / 512.0f);
    rstd = __builtin_amdgcn_rsqf(fmaxf(q * (1.0f / 512.0f) - mu * mu, 0.f) + EPS);
}

__device__ __forceinline__ void mixer_a_unit(LAS unsigned char* lds, int ua, const MixArgs& A, int wave, int lane_in, int strip = 0) {
    int lane = lane_in; asm volatile("" : "+v"(lane));
    const bool smp = ua >= NA_P;
    const int r0 = smp ? MP + 64 * (ua - NA_P) : 64 * ua, jh = smp ? 0 : (ua & 1), rc = r0 - 64 * jh, nv = 64 * (jh + 1), nks = nv >> 5;
    LAS f32x2v* stats = (LAS f32x2v*)(lds + LDS_STATS_OFF);
    { const int tid = wave * 64 + lane; if (tid < nv) { float mu, rstd; ln_stats_row(A.LNS, rc + tid, mu, rstd); stats[tid] = (f32x2v){mu, rstd}; } }
    const int h = wave, l15 = lane & 15, kg = lane >> 4;
    const bf16* Wb = smp ? A.WSS + (size_t)h * 64 * 64 : A.WST + (size_t)h * 128 * 128; const int wpitch = smp ? 64 : 128;
    bf16x8 bfr[4][4];
#pragma unroll
    for (int tf = 0; tf < 4; ++tf)
#pragma unroll
        for (int ks = 0; ks < 4; ++ks) if (ks < nks) bfr[tf][ks] = *(const bf16x8*)(Wb + (size_t)(64 * jh + 16 * tf + l15) * wpitch + 32 * ks + 8 * kg);
    __syncthreads();
    {
        const f32x4 g0 = *(const f32x4*)(A.ln_g + 8 * lane), g1 = *(const f32x4*)(A.ln_g + 8 * lane + 4), b0 = *(const f32x4*)(A.ln_b + 8 * lane), b1 = *(const f32x4*)(A.ln_b + 8 * lane + 4);
#pragma unroll 1
        for (int i0 = 0; i0 < ((strip & 4) ? 0 : nv); i0 += 32) {
            v4u raw[4];
#pragma unroll
            for (int ii = 0; ii < 4; ++ii) raw[ii] = *(const v4u*)(A.ZZ + (size_t)(rc + i0 + 8 * ii + wave) * ZP + 512 + 8 * lane);
#pragma unroll
            for (int ii = 0; ii < 4; ++ii) {
                const int s = i0 + 8 * ii + wave; const f32x2v st = stats[s];
                const f32x4 x0 = (unpack4((u32x2){raw[ii].x, raw[ii].y}) - st.x) * st.y * g0 + b0, x1 = (unpack4((u32x2){raw[ii].z, raw[ii].w}) - st.x) * st.y * g1 + b1;
                LAS u32x2* dst = (LAS u32x2*)(lds + s * VI_PITCH + 16 * lane);
                dst[0] = pack4(x0); dst[1] = pack4(x1);
                if (smp) { float* ov = A.o_v + (size_t)(rc + s - MP) * DA + 8 * lane; *(f32x4*)ov = x0; *(f32x4*)(ov + 4) = x1; }
            }
        }
    }
    __syncthreads();
    {
        u32x2 urc[4];
#pragma unroll
        for (int tf = 0; tf < 4; ++tf) urc[tf] = *(const u32x2*)(A.ZZ + (size_t)(r0 + 16 * tf + l15) * ZP + h * 64 + 4 * kg);
        float bias[4];
#pragma unroll
        for (int tf = 0; tf < 4; ++tf) { const int tl = 64 * jh + 16 * tf + l15; bias[tf] = A.a_bias[h * 128 + (smp ? (tl & 7) : tl)]; }
#pragma unroll 1
        for (int df = 0; df < ((strip & 8) ? 0 : 4); ++df) {
            u32x2 urn[4];
            const int dn = df < 3 ? df + 1 : 3;
#pragma unroll
            for (int tf = 0; tf < 4; ++tf) urn[tf] = *(const u32x2*)(A.ZZ + (size_t)(r0 + 16 * tf + l15) * ZP + h * 64 + 16 * dn + 4 * kg);
            bf16x8 afr[4];
#pragma unroll
            for (int ks = 0; ks < 4; ++ks) if (ks < nks) {
#pragma unroll
                for (int j = 0; j < 8; ++j) afr[ks][j] = *(const LAS short*)(lds + (32 * ks + 8 * kg + j) * VI_PITCH + 2 * (h * 64 + 16 * df + l15));
            }
#pragma unroll
            for (int tf = 0; tf < 4; ++tf) {
                f32x4 acc = (f32x4){0.f, 0.f, 0.f, 0.f};
#pragma unroll
                for (int ks = 0; ks < 4; ++ks) if (ks < nks) acc = __builtin_amdgcn_mfma_f32_16x16x32_bf16(afr[ks], bfr[tf][ks], acc, 0, 0, 0);
                *(u32x2*)(A.YC + (size_t)(r0 + 16 * tf + l15) * D + h * 64 + 16 * df + 4 * kg) = pack4(unpack4(urc[tf]) * (acc + bias[tf]));
            }
#pragma unroll
            for (int tf = 0; tf < 4; ++tf) urc[tf] = urn[tf];
        }
    }
    __syncthreads();
}

template <int MAXP> struct PStage { v4u val[MAXP]; };
template <int MAXP>
__device__ __forceinline__ void pstage_load(PStage<MAXP>& S, int nrows, const bf16* zsrc, int pfirst, int tid) {
#pragma unroll
    for (int i = 0; i < MAXP; ++i) { const int c = tid + i * (NWAVES * 64), row = c >> 5, c8 = 8 * (c & 31), p = pfirst + row;
        if (c < nrows * 32) { S.val[i] = *(const v4u*)(zsrc + (size_t)(p >= 0 ? p : 0) * ZP + c8); if (p < 0) S.val[i] = (v4u){0u, 0u, 0u, 0u}; } }
}
template <int MAXP>
__device__ __forceinline__ void pstage_store(const PStage<MAXP>& S, LAS unsigned char* dst, int nrows, int tid) {
#pragma unroll
    for (int i = 0; i < MAXP; ++i) { const int c = tid + i * (NWAVES * 64), row = c >> 5, c8 = 8 * (c & 31);
        if (c < nrows * 32) *(LAS v4u*)(dst + row * 512 + 2 * c8) = S.val[i]; }
}
template <int H>
__device__ __forceinline__ void sstage(LAS unsigned char* dst, int nrows, int seq0, const bf16* zsrc, const float* st, float* ocopy, int tid) {
#pragma unroll 1
    for (int c0 = tid; c0 < nrows * 32; c0 += 4 * NWAVES * 64) {
        f32x4 fa[4], fb[4]; v4u zv[4];
#pragma unroll
        for (int i = 0; i < 4; ++i) { const int c = c0 + i * (NWAVES * 64), row = c >> 5, c8 = 8 * (c & 31), q = row / (H + 8), j = row - q * (H + 8), n = seq0 + q;
            if (c < nrows * 32) { const float* sp = st + (size_t)(n * H + (j < H ? j : H - 1)) * 256 + c8; fa[i] = *(const f32x4*)sp; fb[i] = *(const f32x4*)(sp + 4);
                zv[i] = *(const v4u*)(zsrc + (size_t)(8 * n + (j >= H ? j - H : 0)) * ZP + c8); } }
#pragma unroll
        for (int i = 0; i < 4; ++i) { const int c = c0 + i * (NWAVES * 64), row = c >> 5, c8 = 8 * (c & 31), q = row / (H + 8), j = row - q * (H + 8), n = seq0 + q;
            if (c < nrows * 32) { const u32x2 pa = pack4(fa[i]), pb = pack4(fb[i]); const v4u pv = (v4u){pa.x, pa.y, pb.x, pb.y};
                *(LAS v4u*)(dst + row * 512 + 2 * c8) = j < H ? pv : zv[i];
                if (H == 30 && j >= 8 && j < H) { float* oc = ocopy + (size_t)(n * 30 + j - 8) * 256 + c8; *(f32x4*)oc = fa[i]; *(f32x4*)(oc + 4) = fb[i]; } } }
    }
}
__device__ __forceinline__ void mixer_bc_unit(LAS unsigned char* lds, int ub, const MixArgs& A, int wave, int lane_in, int strip = 0) {
    int lane = lane_in; asm volatile("" : "+v"(lane));
    const bool smp = ub >= NBC_P;
    const int tid = wave * 64 + lane, c4 = 4 * lane;
    const int seq0 = smp ? 4 * (ub - NBC_P) : 0, r0 = smp ? MP + 8 * seq0 : 64 * ub, b = r0 >> 11, t0 = r0 & 2047;
    const bf16* zb_ = smp ? A.ZZ + (size_t)MP * ZP : A.ZZ + (size_t)(b * SEQ) * ZP;
    {
        f32x4 ta[2], tb[2];
#pragma unroll
        for (int i = 0; i < 2; ++i) { const int c = tid + i * (NWAVES * 64); if (c < 31 * 32) { const float* sp = A.bw + (c >> 5) * 256 + 8 * (c & 31); ta[i] = *(const f32x4*)sp; tb[i] = *(const f32x4*)(sp + 4); } }
        if (!smp) {
            PStage<6> SB; PStage<5> SC;
            pstage_load(SB, 94, zb_ + 1024, t0 - 30, tid); pstage_load(SC, 66, zb_ + 1280, t0 - 2, tid);
            pstage_store(SB, lds + LDS_WB, 94, tid); pstage_store(SC, lds + LDS_WC, 66, tid);
        } else {
            sstage<30>(lds + LDS_WB, 4 * 38, seq0, zb_ + 1024, A.st_b, A.o_cbs, tid);
            sstage<2>(lds + LDS_WC, 4 * 10, seq0, zb_ + 1280, A.st_c, nullptr, tid);
        }
#pragma unroll
        for (int i = 0; i < 2; ++i) { const int c = tid + i * (NWAVES * 64); if (c < 31 * 32) { const u32x2 pa = pack4(ta[i]), pb = pack4(tb[i]); *(LAS v4u*)(lds + LDS_WW + (c >> 5) * 512 + 16 * (c & 31)) = (v4u){pa.x, pa.y, pb.x, pb.y}; } }
    }
    __syncthreads();
    if (!smp || wave < 4) {
        const int rowbase = smp ? MP + 8 * (seq0 + wave) : r0 + 8 * wave;
        const LAS unsigned char* wpB = lds + LDS_WB + (smp ? 38 * wave : 8 * wave) * 512 + 8 * lane;
        const LAS unsigned char* wpC = lds + LDS_WC + (smp ? 10 * wave : 8 * wave) * 512 + 8 * lane;
        u32x2 zbr[8];
#pragma unroll
        for (int r = 0; r < 8; ++r) zbr[r] = *(const u32x2*)(A.ZZ + (size_t)(rowbase + r) * ZP + 1536 + c4);
        f32x4 acc[8]; const f32x4 cb = *(const f32x4*)(A.bb + c4);
#pragma unroll
        for (int r = 0; r < 8; ++r) acc[r] = cb;
        const LAS unsigned char* wpW = lds + LDS_WW + 8 * lane;
#pragma unroll 1
        for (int k = 0; k < ((strip & 2) ? 1 : 31); ++k) {
            const f32x4 wk = unpack4(*(const LAS u32x2*)(wpW + k * 512));
#pragma unroll
            for (int r = 0; r < 8; ++r) acc[r] += wk * unpack4(*(const LAS u32x2*)(wpB + (r + k) * 512));
        }
        const f32x4 lg = *(const f32x4*)(A.blg + c4), lb = *(const f32x4*)(A.blb + c4);
        float s[8], q[8];
#pragma unroll
        for (int r = 0; r < 8; ++r) { s[r] = sum4(acc[r]); q[r] = sumsq4(acc[r]); }
#pragma unroll
        for (int o = 1; o < 64; o <<= 1)
#pragma unroll
            for (int r = 0; r < 8; ++r) { s[r] += __shfl_xor(s[r], o); q[r] += __shfl_xor(q[r], o); }
#pragma unroll
        for (int r = 0; r < 8; ++r) {
            const float mu = s[r] * (1.0f / 256.0f);
            const float rstd = __builtin_amdgcn_rsqf(fmaxf(q[r] * (1.0f / 256.0f) - mu * mu, 0.f) + EPS);
            f32x4 y = (acc[r] - mu) * rstd * lg + lb;
#pragma unroll
            for (int i = 0; i < 4; ++i) y[i] = y[i] * pg8::fast_sigmoid(y[i]);
            *(u32x2*)(A.YC + (size_t)(rowbase + r) * D + 512 + c4) = pack4(y);
        }
        const f32x4 k0 = *(const f32x4*)(A.cw + c4), k1 = *(const f32x4*)(A.cw + 256 + c4), k2 = *(const f32x4*)(A.cw + 512 + c4);
#pragma unroll
        for (int r = 0; r < 8; ++r) {
            const f32x4 cv = k0 * unpack4(*(const LAS u32x2*)(wpC + r * 512)) + k1 * unpack4(*(const LAS u32x2*)(wpC + (r + 1) * 512)) + k2 * unpack4(*(const LAS u32x2*)(wpC + (r + 2) * 512));
            *(u32x2*)(A.YC + (size_t)(rowbase + r) * D + 768 + c4) = pack4(unpack4(zbr[r]) * cv);
        }
    }
    __syncthreads();
}

__global__ void __launch_bounds__(NWAVES * 64, 2) fwd_kernel(Args args) {
    extern __shared__ __attribute__((aligned(16))) unsigned char lds_raw[];
    LAS unsigned char* lds = (LAS unsigned char*)lds_raw;
    volatile LAS unsigned* MISC = (volatile LAS unsigned*)(lds + MISC_OFF);
    const int tid = threadIdx.x, lane = tid & 63, wave = __builtin_amdgcn_readfirstlane(tid >> 6);
    const int G = gridDim.x, bx = blockIdx.x;
    const int gw = bx * NWAVES + wave, NGW = G * NWAVES;
    unsigned char* ws = args.ws; float* out = args.out;
    gu32* ctl = (gu32*)(ws + WS_CTL);
    for (int u = tid; u < (LDS_BYTES - LDSCTL_OFF) / 4; u += NWAVES * 64) ((LAS unsigned*)(lds + LDSCTL_OFF))[u] = 0u;
    __syncthreads();
    XcdBarrier bar; bar.bar = (unsigned*)(ctl + CW_BAR); bar.x = 0; bar.st = nullptr;
    if (N_LAUNCHES == 1) bar = xcd_barrier_post((unsigned*)(ctl + CW_BAR), MISC + 8);
    const int lo = args.ph_lo, hi = args.ph_hi;
#define IN(k) (lo <= (k) && (k) < hi)
#ifndef PROBE_DUP
#define PROBE_DUP -1
#endif
#define REPS(k) ((((k) - 1) % 5 + 1 == PROBE_DUP && (k) >= 1 && (k) <= 10) || ((k) == 0 && PROBE_DUP == 0) ? 2 : 1)
#define SEAM(k) do { if (IN(k) && IN((k) + 1)) xcd_barrier(bar); } while (0)

    const float* x_prompt = args.in[0]; const float* x_sample = args.in[1];
    bf16* XB = (bf16*)(ws + WS_XB); bf16* ZZ = (bf16*)(ws + WS_ZZ); bf16* YC = (bf16*)(ws + WS_YC); bf16* HFF = (bf16*)(ws + WS_HFF);

    if (IN(0)) for (int rep_ = 0; rep_ < REPS(0); ++rep_) {
        LAS float* scr = (LAS float*)(lds + wave * 16384);
        constexpr int I1 = (D / 64) * (DIN / 32), I2 = (D / 64) * (D / 32), I3 = (D / 64) * (DFF / 32), I4 = (DFF / 64) * (D / 32), IL = I1 + I2 + I3 + I4;
        for (int it = gw; it < DEPTH * IL; it += NGW) {
            const int l = it / IL; int r = it - l * IL; unsigned char* wl = ws + WS_W + (size_t)l * W_LAYER;
            if (r < I1) { const int nb = r % (DIN / 32), kb = r / (DIN / 32);
                transpose_item(args.in[5] + (size_t)l * D * DIN, D, DIN, (bf16*)(wl + W1_OFF), args.in[4] + l * D, 64 * kb, win_src_col(32 * nb), 32 * nb, scr, lane); continue; }
            r -= I1;
            if (r < I2) { const int nb = r % (D / 32), kb = r / (D / 32);
                transpose_item(args.in[15] + (size_t)l * D * D, D, D, (bf16*)(wl + W2_OFF), nullptr, 64 * kb, 32 * nb, 32 * nb, scr, lane); continue; }
            r -= I2;
            if (r < I3) { const int nb = r % (DFF / 32), kb = r / (DFF / 32);
                transpose_item(args.in[17] + (size_t)l * D * DFF, D, DFF, (bf16*)(wl + W3_OFF), args.in[16] + l * D, 64 * kb, 32 * nb, 32 * nb, scr, lane); continue; }
            r -= I3;
            { const int nb = r % (D / 32), kb = r / (D / 32);
                transpose_item(args.in[18] + (size_t)l * DFF * D, DFF, D, (bf16*)(wl + W4_OFF), nullptr, 64 * kb, 32 * nb, 32 * nb, scr, lane); }
        }
        { bf16* WST = (bf16*)(ws + WS_WST); const float* aws = args.in[8];
          for (int i = bx * (NWAVES * 64) + tid; i < DEPTH * 8 * 128 * 128; i += G * NWAVES * 64) { const int s = i & 127, t = (i >> 7) & 127; WST[i] = (bf16)f2bf(s <= t ? aws[i] : 0.f); } }
        { bf16* WSS = (bf16*)(ws + WS_WSS); const float* aws = args.in[8];
          for (int i = bx * (NWAVES * 64) + tid; i < DEPTH * 8 * 64 * 64; i += G * NWAVES * 64) { const int s = i & 63, t = (i >> 6) & 63, lh = i >> 12;
              WSS[i] = (bf16)f2bf(((s >> 3) == (t >> 3) && (s & 7) <= (t & 7)) ? aws[(size_t)lh * 128 * 128 + (t & 7) * 128 + (s & 7)] : 0.f); } }
        { float* SS0 = (float*)(ws + WS_SS);
          for (int m = gw; m < M; m += NGW) {
              const float* xr = m < MP ? x_prompt + (size_t)m * D : x_sample + (size_t)(m - MP) * D;
              f32x4 v[4]; float s = 0.f;
#pragma unroll
              for (int j = 0; j < 4; ++j) { v[j] = *(const f32x4*)(xr + 4 * lane + 256 * j); s += sumsq4(v[j]); }
              s = wave_sum(s);
#pragma unroll
              for (int j = 0; j < 4; ++j) *(u32x2*)(XB + (size_t)m * D + 4 * lane + 256 * j) = pack4(v[j]);
              if (lane < 16) SS0[(size_t)m * 16 + lane] = lane == 0 ? s : 0.f;
          } }
    }
    SEAM(0);

#pragma unroll 1
    for (int l = 0; l < DEPTH; ++l) {
        unsigned char* wl = ws + WS_W + (size_t)l * W_LAYER;
        float* SSa = (float*)(ws + WS_SS + (size_t)(2 * l) * SS_STRIDE);
        float* SSb = (float*)(ws + WS_SS + (size_t)(2 * l + 1) * SS_STRIDE);
        float* SSc = (float*)(ws + WS_SS + (size_t)(2 * l + 2) * SS_STRIDE);
        const int pb = 1 + 5 * l;
        if (IN(pb)) for (int rep_ = 0; rep_ < REPS(pb); ++rep_) {
            pg8::Gemm g{XB, (const bf16*)(wl + W1_OFF), M, DIN, D}; pg8::StaticOrder S; S.init(M, DIN, G, bx);
            pg8::EpiG1 E{ZZ, SSa, out + O_CBP + (size_t)l * 8 * 30 * DB, out + O_CCP + (size_t)l * 8 * 2 * DC, out + O_CBS + (size_t)l * NSEQ_S * 30 * DB, out + O_CCS + (size_t)l * NSEQ_S * 2 * DC, (float*)(ws + WS_LNS)};
            pg8::gemm_phase<pg8::EpiG1, pg8::StaticOrder, true, true>(lds, g, S, E);
        }
        SEAM(pb);
        if (IN(pb + 1)) for (int rep_ = 0; rep_ < REPS(pb + 1); ++rep_) {
            MixArgs A;
            A.ZZ = ZZ; A.YC = YC; A.LNS = (const float*)(ws + WS_LNS); A.WST = (const bf16*)(ws + WS_WST) + (size_t)l * 8 * 128 * 128;
            A.ln_g = args.in[6] + l * DA; A.ln_b = args.in[7] + l * DA; A.a_bias = args.in[9] + l * 8 * 128; A.WSS = (const bf16*)(ws + WS_WSS) + (size_t)l * 8 * 64 * 64;
            A.bw = args.in[10] + l * 31 * DB; A.bb = args.in[11] + l * DB; A.blg = args.in[12] + l * DB; A.blb = args.in[13] + l * DB; A.cw = args.in[14] + l * 3 * DC;
            A.st_b = args.in[2] + (size_t)l * NSEQ_S * 30 * DB; A.st_c = args.in[3] + (size_t)l * NSEQ_S * 2 * DC;
            A.o_cbs = out + O_CBS + (size_t)l * NSEQ_S * 30 * DB; A.o_v = out + O_V + (size_t)l * NSEQ_S * TS * DA;
#if PROBE_PRE
#pragma unroll 1
            for (int u = bx; u < N_MIX_UNITS; u += G) {
                if (u < NA_P) { if (PROBE_PRE & 1) mixer_a_unit(lds, u, A, wave, lane, PROBE_STRIP); }
                else if (u < NA_P + NBC_P) { if (PROBE_PRE & 2) mixer_bc_unit(lds, u - NA_P, A, wave, lane, PROBE_STRIP); }
                else if (u < NA_P + NBC_P + NA_S) { if (PROBE_PRE & 1) mixer_a_unit(lds, NA_P + (u - NA_P - NBC_P), A, wave, lane, PROBE_STRIP); }
                else { if (PROBE_PRE & 2) mixer_bc_unit(lds, NBC_P + (u - NA_P - NBC_P - NA_S), A, wave, lane, PROBE_STRIP); }
            }
#endif
#pragma unroll 1
            for (int u = bx; u < N_MIX_UNITS; u += G) {
                if (u < NA_P) mixer_a_unit(lds, u, A, wave, lane);
                else if (u < NA_P + NBC_P) mixer_bc_unit(lds, u - NA_P, A, wave, lane);
                else if (u < NA_P + NBC_P + NA_S) mixer_a_unit(lds, NA_P + (u - NA_P - NBC_P), A, wave, lane);
                else mixer_bc_unit(lds, NBC_P + (u - NA_P - NBC_P - NA_S), A, wave, lane);
            }
        }
        SEAM(pb + 1);
        if (IN(pb + 2)) {
            pg8::Gemm g{YC, (const bf16*)(wl + W2_OFF), M, D, D}; pg8::StaticOrder S; S.init(M, D, G, bx);
            pg8::EpiRes E{l == 0 ? x_prompt : out, l == 0 ? x_sample : out + (size_t)MP * D, out, XB, SSb};
            pg8::gemm_phase<pg8::EpiRes, pg8::StaticOrder, true, true>(lds, g, S, E);
        }
        SEAM(pb + 2);
        if (IN(pb + 3)) for (int rep_ = 0; rep_ < REPS(pb + 3); ++rep_) {
            pg8::Gemm g{XB, (const bf16*)(wl + W3_OFF), M, DFF, D}; pg8::StaticOrder S; S.init(M, DFF, G, bx);
            pg8::EpiG3 E{HFF, SSb};
            pg8::gemm_phase<pg8::EpiG3, pg8::StaticOrder, true, true>(lds, g, S, E);
        }
        SEAM(pb + 3);
        if (IN(pb + 4)) {
            pg8::Gemm g{HFF, (const bf16*)(wl + W4_OFF), M, D, DFF}; pg8::StaticOrder S; S.init(M, D, G, bx);
            pg8::EpiRes E{out, out + (size_t)MP * D, out, XB, SSc};
            pg8::gemm_phase<pg8::EpiRes, pg8::StaticOrder, true, true>(lds, g, S, E);
        }
        SEAM(pb + 4);
    }
    if (IN(11)) {
        const float* gf = args.in[19];
        f32x4 gv[4];
#pragma unroll
        for (int j = 0; j < 4; ++j) gv[j] = *(const f32x4*)(gf + 4 * lane + 256 * j);
        for (int m = gw; m < M; m += NGW) {
            float* xr = out + (size_t)m * D; f32x4 v[4]; float s = 0.f;
#pragma unroll
            for (int j = 0; j < 4; ++j) { v[j] = *(const f32x4*)(xr + 4 * lane + 256 * j); s += sumsq4(v[j]); }
            const float rstd = __builtin_amdgcn_rsqf(wave_sum(s) * (1.0f / 1024.0f) + EPS);
#pragma unroll
            for (int j = 0; j < 4; ++j) *(f32x4*)(xr + 4 * lane + 256 * j) = v[j] * rstd * gv[j];
        }
    }
#undef IN
#undef SEAM
}

extern "C" void kernel_launch(void* const* d_in, const int* in_sizes, int n_in, void* d_out, int out_size, void* d_ws, size_t ws_size, hipStream_t stream) {
    static int grid = 0;
    if (grid == 0) {
        if (n_in != 20 || (size_t)out_size != O_END || ws_size < WS_END) { fprintf(stderr, "kernel_launch: unexpected shapes: n_in %d out %d ws %zu (need out %zu, ws >= %zu)\n", n_in, out_size, ws_size, (size_t)O_END, (size_t)WS_END); grid = -1; return; }
        int dev = 0, cus = 0, per_cu = 0;
        if (hipGetDevice(&dev) != hipSuccess || hipDeviceGetAttribute(&cus, hipDeviceAttributeMultiprocessorCount, dev) != hipSuccess) { grid = -1; return; }
        if (hipFuncSetAttribute((const void*)fwd_kernel, hipFuncAttributeMaxDynamicSharedMemorySize, LDS_BYTES) != hipSuccess) { fprintf(stderr, "kernel_launch: hipFuncSetAttribute failed\n"); grid = -1; return; }
        if (hipOccupancyMaxActiveBlocksPerMultiprocessor(&per_cu, (const void*)fwd_kernel, NWAVES * 64, LDS_BYTES) != hipSuccess || per_cu < 1) { fprintf(stderr, "kernel_launch: occupancy query says %d blocks per CU\n", per_cu); (void)hipGetLastError(); per_cu = 1; }
        grid = cus;
        fprintf(stderr, "kernel_launch: grid %d (cus %d, per_cu %d)\n", grid, cus, per_cu);
    }
    if (grid < 0) return;
    if (hipMemsetAsync((char*)d_ws + WS_CTL, 0, CTL_ZERO_BYTES, stream) != hipSuccess) return;
    Args a{};
    for (int i = 0; i < 20; ++i) a.in[i] = (const float*)d_in[i];
    a.out = (float*)d_out; a.ws = (unsigned char*)d_ws;
    for (int li = 0; li < N_LAUNCHES; ++li) {
        a.ph_lo = (N_LAUNCHES == 1) ? 0 : li; a.ph_hi = (N_LAUNCHES == 1) ? NPH : li + 1; a.li = li;
        hipLaunchKernelGGL(fwd_kernel, dim3(grid), dim3(NWAVES * 64), LDS_BYTES, stream, a);
        const hipError_t le = hipPeekAtLastError();
        if (le != hipSuccess) { fprintf(stderr, "kernel_launch: launch %d failed: %s\n", li, hipGetErrorName(le)); break; }
    }
}
```
